# Optimizing an MI355X kernel written in HIP

```python
import math
import jax, jax.numpy as jnp
from jax import lax
import numpy as np

D_MODEL = 1024
BATCH = 2
SEQ = 8192
DEPTH = 1

M_HEADS = 4
M_HEAD_DIM = D_MODEL // M_HEADS
M_WIDTH = M_HEADS * M_HEAD_DIM
M_CONV = 4
M_CHUNK = 128
R_HEAD_DIM = 64
R_WIDTH = D_MODEL
R_HEADS = R_WIDTH // R_HEAD_DIM
R_DECAY_RANK = 64
R_AAA_RANK = 64
R_GATE_RANK = 128
R_GN_EPS = 64e-5
D_FF = 128 * ((8 * D_MODEL // 3 + 127) // 128)
LN_EPS = 1e-5
ALPHA = (2 * DEPTH) ** 0.25
BETA = (8 * DEPTH) ** -0.25
R_COLS = 3 * R_WIDTH + R_DECAY_RANK + R_AAA_RANK + R_GATE_RANK
W_IN_SPLITS = (M_WIDTH, M_WIDTH, M_WIDTH, M_WIDTH, M_HEADS, M_HEADS, R_COLS, D_MODEL, D_MODEL)
W_IN_COLS = 4 * M_WIDTH + 2 * M_HEADS + R_COLS + 2 * D_MODEL
R_SPLITS = (R_WIDTH, R_WIDTH, R_WIDTH, R_DECAY_RANK, R_AAA_RANK, R_GATE_RANK)

kernel_name = 'hybrid_mlstm_rwkv7_macaron_deepnorm'


def _offsets(sizes):
    return [int(o) for o in np.cumsum(np.asarray(sizes))[:-1]]


def layer_norm(x, g, b, eps=LN_EPS):
    xf = x.astype(jnp.float32)
    mu = jnp.mean(xf, axis=-1, keepdims=True)
    var = jnp.mean(jnp.square(xf - mu), axis=-1, keepdims=True)
    return ((xf - mu) * lax.rsqrt(var + eps) * g + b).astype(x.dtype)


def swiglu(x, w_gate, w_up, w_down):
    return (jax.nn.silu(x @ w_gate) * (x @ w_up)) @ w_down


def causal_dwconv(x, w, b):
    k_w = w.shape[0]
    t = x.shape[1]
    xp = jnp.pad(x, ((0, 0), (k_w - 1, 0), (0, 0)))
    out = b
    for j in range(k_w):
        out = out + xp[:, j:j + t] * w[j]
    return out


def mlstm_chunkwise(q, k, v, i_pre, log_f):
    bsz, nh, t, dh = q.shape
    nc = t // M_CHUNK
    q = q.reshape(bsz, nh, nc, M_CHUNK, dh) * dh ** -0.5
    k = k.reshape(bsz, nh, nc, M_CHUNK, dh)
    v = v.reshape(bsz, nh, nc, M_CHUNK, dh)
    i_pre = i_pre.reshape(bsz, nh, nc, M_CHUNK)
    b = jnp.cumsum(log_f.reshape(bsz, nh, nc, M_CHUNK), axis=-1)
    g = b[..., -1]
    a = g[..., None] - b + i_pre
    m_loc = jnp.max(a, axis=-1)
    wa = jnp.exp(a - m_loc[..., None])
    c_loc = jnp.einsum('bhcs,bhcsk,bhcsv->bhckv', wa, k, v)
    n_loc = jnp.einsum('bhcs,bhcsk->bhck', wa, k)

    def step(carry, xs):
        c_st, n_st, m_st = carry
        g_c, m_c, cc, nn = xs
        m_new = jnp.maximum(g_c + m_st, m_c)
        s_old = jnp.exp(g_c + m_st - m_new)
        s_new = jnp.exp(m_c - m_new)
        c_next = s_old[..., None, None] * c_st + s_new[..., None, None] * cc
        n_next = s_old[..., None] * n_st + s_new[..., None] * nn
        return (c_next, n_next, m_new), (c_st, n_st, m_st)

    init = (jnp.zeros((bsz, nh, dh, dh), q.dtype), jnp.zeros((bsz, nh, dh), q.dtype),
            jnp.zeros((bsz, nh), q.dtype))
    xs = (jnp.moveaxis(g, 2, 0), jnp.moveaxis(m_loc, 2, 0), jnp.moveaxis(c_loc, 2, 0),
          jnp.moveaxis(n_loc, 2, 0))
    _, (c_prev, n_prev, m_prev) = lax.scan(step, init, xs)
    c_prev = jnp.moveaxis(c_prev, 0, 2)
    n_prev = jnp.moveaxis(n_prev, 0, 2)
    m_prev = jnp.moveaxis(m_prev, 0, 2)

    causal = jnp.tril(jnp.ones((M_CHUNK, M_CHUNK), dtype=bool))
    d_log = b[..., :, None] - b[..., None, :] + i_pre[..., None, :]
    d_log = jnp.where(causal, d_log, -jnp.inf)
    inter = b + m_prev[..., None]
    m_t = jnp.maximum(jnp.max(d_log, axis=-1), inter)
    s = jnp.einsum('bhctd,bhcsd->bhcts', q, k) * jnp.exp(d_log - m_t[..., None])
    s_inter = jnp.exp(inter - m_t)
    num = (jnp.einsum('bhcts,bhcsv->bhctv', s, v)
           + s_inter[..., None] * jnp.einsum('bhctk,bhckv->bhctv', q, c_prev))
    den = jnp.sum(s, axis=-1) + s_inter * jnp.einsum('bhctk,bhck->bhct', q, n_prev)
    h = num / jnp.maximum(jnp.abs(den), jnp.exp(-m_t))[..., None]
    return h.reshape(bsz, nh, t, dh)


def rwkv7_recurrence(r, w, k, v, a, b):
    bsz, _, nh, n = r.shape

    def step(st, xs):
        r_t, w_t, k_t, v_t, a_t, b_t = xs
        sa = jnp.einsum('bhvk,bhk->bhv', st, a_t)
        st = st * w_t[:, :, None, :] + sa[..., None] * b_t[:, :, None, :] + v_t[..., None] * k_t[:, :, None, :]
        return st, jnp.einsum('bhvk,bhk->bhv', st, r_t)

    xs = tuple(jnp.moveaxis(z, 1, 0) for z in (r, w, k, v, a, b))
    _, y = lax.scan(step, jnp.zeros((bsz, nh, n, n), r.dtype), xs)
    return jnp.moveaxis(y, 0, 1)


def token_mixer(h, w_in, m_conv_w, m_conv_b, m_i_bias, m_f_bias, m_norm_g, r_mu, r_w0, r_w2,
                r_a0, r_a2, r_g2, r_k_k, r_k_a, r_r_k, r_gn_g, r_gn_b, w_branch_a, w_branch_b, w_out):
    bsz, t, _ = h.shape
    f32 = jnp.float32
    p = h @ w_in
    mq, mk, mv, mo, mi, mf, rc, gate_a, gate_b = jnp.split(p, _offsets(W_IN_SPLITS), axis=-1)

    qk = jax.nn.silu(causal_dwconv(jnp.concatenate([mq, mk], axis=-1), m_conv_w, m_conv_b))
    mq, mk = jnp.split(qk, 2, axis=-1)

    def mheads(z):
        return z.reshape(bsz, t, M_HEADS, M_HEAD_DIM).transpose(0, 2, 1, 3).astype(f32)

    i_pre = (mi + m_i_bias).astype(f32).transpose(0, 2, 1)
    log_f = jax.nn.log_sigmoid((mf + m_f_bias).astype(f32)).transpose(0, 2, 1)
    hm = mlstm_chunkwise(mheads(mq), mheads(mk), mheads(mv), i_pre, log_f)
    mu = jnp.mean(hm, axis=-1, keepdims=True)
    var = jnp.mean(jnp.square(hm - mu), axis=-1, keepdims=True)
    hm = ((hm - mu) * lax.rsqrt(var + LN_EPS)).transpose(0, 2, 1, 3).reshape(bsz, t, M_WIDTH).astype(h.dtype)
    hm = hm * m_norm_g * jax.nn.sigmoid(mo)
    y_a = hm @ w_branch_a

    rc_prev = jnp.pad(rc, ((0, 0), (1, 0), (0, 0)))[:, :-1]
    rc = rc + (rc_prev - rc) * r_mu
    rr, rk, rv, wd, ad, gd = jnp.split(rc, _offsets(R_SPLITS), axis=-1)
    w_log = -jax.nn.softplus(-(r_w0 + jnp.tanh(wd) @ r_w2)) - 0.5
    decay = jnp.exp(-jnp.exp(w_log.astype(f32)))
    a = jax.nn.sigmoid(r_a0 + ad @ r_a2)
    g = jax.nn.sigmoid(gd) @ r_g2

    def rheads(z):
        return z.reshape(bsz, t, R_HEADS, R_HEAD_DIM).astype(f32)

    kk = rheads(rk * r_k_k)
    kk = kk / jnp.maximum(jnp.sqrt(jnp.sum(jnp.square(kk), axis=-1, keepdims=True)), 1e-12)
    rk = rk * (1 + (a - 1) * r_k_a)
    r_h, k_h, v_h, a_h = rheads(rr), rheads(rk), rheads(rv), rheads(a)
    yr = rwkv7_recurrence(r_h, rheads(decay), k_h, v_h, -kk, kk * a_h)
    mu = jnp.mean(yr, axis=-1, keepdims=True)
    var = jnp.mean(jnp.square(yr - mu), axis=-1, keepdims=True)
    yr = ((yr - mu) * lax.rsqrt(var + R_GN_EPS)).reshape(bsz, t, R_WIDTH) * r_gn_g + r_gn_b
    bonus = jnp.sum(r_h * k_h * r_r_k, axis=-1, keepdims=True) * v_h
    yr = (yr + bonus.reshape(bsz, t, R_WIDTH)).astype(h.dtype) * g
    y_b = yr @ w_branch_b

    merged = jax.nn.sigmoid(gate_a) * y_a + jax.nn.sigmoid(gate_b) * y_b
    return merged @ w_out


def setup_inputs(seed: int = 0) -> dict:
    key = jax.random.key(seed)
    ks = iter(jax.random.split(key, 48))
    d = D_MODEL

    def nrm(shape, std):
        return jax.random.normal(next(ks), (DEPTH,) + shape, jnp.float32) * std

    x = jax.random.normal(next(ks), (BATCH, SEQ, d), jnp.float32)
    ffn1_w_gate = nrm((d, D_FF), d ** -0.5)
    ffn1_w_up = nrm((d, D_FF), BETA * d ** -0.5)
    ffn1_w_down = nrm((D_FF, d), BETA * D_FF ** -0.5)
    ln1_g = 1.0 + nrm((d,), 0.02)
    ln1_b = nrm((d,), 0.02)
    col_scale = np.ones((W_IN_COLS,), np.float32)
    mv0 = 2 * M_WIDTH
    col_scale[mv0:mv0 + M_WIDTH] = BETA
    rv0 = 4 * M_WIDTH + 2 * M_HEADS + 2 * R_WIDTH
    col_scale[rv0:rv0 + R_WIDTH] = BETA
    w_in = nrm((d, W_IN_COLS), d ** -0.5) * jnp.asarray(col_scale)
    m_conv_w = nrm((M_CONV, 2 * M_WIDTH), M_CONV ** -0.5)
    m_conv_b = nrm((2 * M_WIDTH,), 0.02)
    m_i_bias = nrm((M_HEADS,), 0.1)
    m_f_bias = jnp.linspace(3.0, 6.0, M_HEADS, dtype=jnp.float32) + nrm((M_HEADS,), 0.1)
    m_norm_g = 1.0 + nrm((M_WIDTH,), 0.02)
    r_mu = jax.random.uniform(next(ks), (DEPTH, R_COLS), jnp.float32, 0.2, 0.8)
    ramp = jnp.arange(R_WIDTH, dtype=jnp.float32) / (R_WIDTH - 1)
    r_w0 = -6.0 + 5.0 * ramp ** 0.85 + nrm((R_WIDTH,), 0.1)
    r_w2 = nrm((R_DECAY_RANK, R_WIDTH), 0.1 * R_DECAY_RANK ** -0.5)
    r_a0 = nrm((R_WIDTH,), 0.1)
    r_a2 = nrm((R_AAA_RANK, R_WIDTH), 0.1 * R_AAA_RANK ** -0.5)
    r_g2 = nrm((R_GATE_RANK, R_WIDTH), R_GATE_RANK ** -0.5)
    r_k_k = 0.85 + nrm((R_WIDTH,), 0.02)
    r_k_a = 1.0 + nrm((R_WIDTH,), 0.02)
    r_r_k = nrm((R_HEADS, R_HEAD_DIM), 0.1)
    r_gn_g = 1.0 + nrm((R_WIDTH,), 0.02)
    r_gn_b = nrm((R_WIDTH,), 0.02)
    w_branch_a = nrm((M_WIDTH, d), BETA * M_WIDTH ** -0.5)
    w_branch_b = nrm((R_WIDTH, d), BETA * R_WIDTH ** -0.5)
    w_out = nrm((d, d), BETA * d ** -0.5)
    ln2_g = 1.0 + nrm((d,), 0.02)
    ln2_b = nrm((d,), 0.02)
    ffn2_w_gate = nrm((d, D_FF), d ** -0.5)
    ffn2_w_up = nrm((d, D_FF), BETA * d ** -0.5)
    ffn2_w_down = nrm((D_FF, d), BETA * D_FF ** -0.5)
    ln3_g = 1.0 + nrm((d,), 0.02)
    ln3_b = nrm((d,), 0.02)
    return {'x': x, 'ffn1_w_gate': ffn1_w_gate, 'ffn1_w_up': ffn1_w_up, 'ffn1_w_down': ffn1_w_down,
            'ln1_g': ln1_g, 'ln1_b': ln1_b, 'w_in': w_in, 'm_conv_w': m_conv_w, 'm_conv_b': m_conv_b,
            'm_i_bias': m_i_bias, 'm_f_bias': m_f_bias, 'm_norm_g': m_norm_g, 'r_mu': r_mu, 'r_w0': r_w0,
            'r_w2': r_w2, 'r_a0': r_a0, 'r_a2': r_a2, 'r_g2': r_g2, 'r_k_k': r_k_k, 'r_k_a': r_k_a,
            'r_r_k': r_r_k, 'r_gn_g': r_gn_g, 'r_gn_b': r_gn_b, 'w_branch_a': w_branch_a,
            'w_branch_b': w_branch_b, 'w_out': w_out, 'ln2_g': ln2_g, 'ln2_b': ln2_b,
            'ffn2_w_gate': ffn2_w_gate, 'ffn2_w_up': ffn2_w_up, 'ffn2_w_down': ffn2_w_down,
            'ln3_g': ln3_g, 'ln3_b': ln3_b}


def reference(x, ffn1_w_gate, ffn1_w_up, ffn1_w_down, ln1_g, ln1_b, w_in, m_conv_w, m_conv_b,
              m_i_bias, m_f_bias, m_norm_g, r_mu, r_w0, r_w2, r_a0, r_a2, r_g2, r_k_k, r_k_a, r_r_k,
              r_gn_g, r_gn_b, w_branch_a, w_branch_b, w_out, ln2_g, ln2_b, ffn2_w_gate, ffn2_w_up,
              ffn2_w_down, ln3_g, ln3_b):
    for l in range(DEPTH):
        x = layer_norm(ALPHA * x + 0.5 * swiglu(x, ffn1_w_gate[l], ffn1_w_up[l], ffn1_w_down[l]),
                       ln1_g[l], ln1_b[l])
        mix = token_mixer(x, w_in[l], m_conv_w[l], m_conv_b[l], m_i_bias[l], m_f_bias[l], m_norm_g[l],
                          r_mu[l], r_w0[l], r_w2[l], r_a0[l], r_a2[l], r_g2[l], r_k_k[l], r_k_a[l],
                          r_r_k[l], r_gn_g[l], r_gn_b[l], w_branch_a[l], w_branch_b[l], w_out[l])
        x = layer_norm(ALPHA * x + mix, ln2_g[l], ln2_b[l])
        x = layer_norm(ALPHA * x + 0.5 * swiglu(x, ffn2_w_gate[l], ffn2_w_up[l], ffn2_w_down[l]),
                       ln3_g[l], ln3_b[l])
    return x
```

```cpp
#include <hip/hip_runtime.h>
#include <hip/hip_cooperative_groups.h>
#include <cstdio>
#include <cstdint>
namespace cg = cooperative_groups;
namespace pg8 {
#define PG8_LAS __attribute__((address_space(3)))
typedef unsigned short bf16_t;
typedef short bf16x8 __attribute__((ext_vector_type(8)));
typedef float f32x4 __attribute__((ext_vector_type(4)));
typedef unsigned u32x4 __attribute__((ext_vector_type(4)));
constexpr int BM = 256, BK = 64, HALF = 128, HTB = HALF * BK * 2  , STAGE_BYTES = 8 * HTB, NXCD = 8, WGM = 8;

__host__ __device__ __forceinline__ int lds_byte(int r, int c) { const int st = (r >> 4) * 2 + (c >> 5), rr = r & 15, cc = c & 31, ob = rr * 64 + cc * 2; return st * 1024 + (ob ^ (((ob >> 9) & 1) << 5)); }
__host__ __device__ __forceinline__ void stage_rc(int b, int& R, int& C) { const int st = b / 1024, sb = b % 1024, swz = sb ^ (((sb >> 9) & 1) << 5); R = (st >> 1) * 16 + swz / 64; C = (st & 1) * 32 + (swz % 64) / 2; }
__host__ __device__ __forceinline__ int perm32(int rho) { const int n = rho >> 4, i = rho & 15; return 8 * (i >> 2) + 4 * n + (i & 3); }

struct Unit { int pm, pn; };
struct Gemm { const bf16_t* A; const bf16_t* Bt; int M, N, K; };

struct StaticOrder {
    int nM, nN, nwg, G, c;
    __host__ __device__ void init(int M, int N, int G_, int c_) { nM = M / BM; nN = N / BM; nwg = nM * nN; G = G_; c = c_; }
    __host__ __device__ bool next(int i, Unit& u) const {
        const long L = (long)i * G + c; if (L >= nwg) return false;
        int wgid = (int)L; { const int q = nwg / NXCD, r = nwg % NXCD, xcd = wgid % NXCD, off = wgid / NXCD; wgid = (xcd < r ? xcd * (q + 1) : r * (q + 1) + (xcd - r) * q) + off; }
        const int nig = WGM * nN, gid = wgid / nig, fm = gid * WGM, gsz = (nM - fm) < WGM ? (nM - fm) : WGM;
        u.pm = fm + ((wgid % nig) % gsz); u.pn = (wgid % nig) / gsz; return true;
    }
    __device__ __forceinline__ void a_ready(const Unit&) const {}
    __device__ __forceinline__ void done(const Unit&) const {}
};

__device__ __forceinline__ unsigned cvt_pk_bf16(float lo, float hi) { unsigned r; asm volatile("v_cvt_pk_bf16_f32 %0, %1, %2" : "=v"(r) : "v"(lo), "v"(hi)); return r; }
__device__ __forceinline__ float bf_lo(unsigned w) { return __uint_as_float(w << 16); }
__device__ __forceinline__ float bf_hi(unsigned w) { return __uint_as_float(w & 0xffff0000u); }
__device__ __forceinline__ float sigmoidf_(float x) { return 1.0f / (1.0f + __expf(-x)); }
__device__ __forceinline__ float siluf_(float x) { return x / (1.0f + __expf(-x)); }

struct EpiSwiGLU {
    static constexpr bool PERM = true, AFTER_DRAIN = false;
    bf16_t* H; int ldh;
    __device__ __forceinline__ void operator()(const f32x4 (&acc)[2][2][4][2], const Unit& u, int wr, int wc, int fr, int fq) const {
        const int row0 = u.pm * BM + wr * 64 + fr, col0 = u.pn * 128 + wc * 32 + 8 * fq;
#pragma unroll
        for (int ai = 0; ai < 2; ++ai)
#pragma unroll
            for (int m = 0; m < 4; ++m) {
                bf16_t* rowp = H + (size_t)(row0 + ai * HALF + m * 16) * ldh + col0;
                const f32x4 g0 = acc[ai][0][m][0], g1 = acc[ai][0][m][1], u0 = acc[ai][1][m][0], u1 = acc[ai][1][m][1];
                u32x4 w;
                w.x = cvt_pk_bf16(siluf_(g0[0]) * u0[0], siluf_(g0[1]) * u0[1]); w.y = cvt_pk_bf16(siluf_(g0[2]) * u0[2], siluf_(g0[3]) * u0[3]);
                w.z = cvt_pk_bf16(siluf_(g1[0]) * u1[0], siluf_(g1[1]) * u1[1]); w.w = cvt_pk_bf16(siluf_(g1[2]) * u1[2], siluf_(g1[3]) * u1[3]);
                *(u32x4*)rowp = w;
            }
    }
};
struct EpiResid {
    static constexpr bool PERM = false, AFTER_DRAIN = false;
    const float* res; float* out; int ldc; float alpha, scale;
    __device__ __forceinline__ void operator()(const f32x4 (&acc)[2][2][4][2], const Unit& u, int wr, int wc, int fr, int fq) const {
        const int row0 = u.pm * BM + wr * 64 + fr, col0 = u.pn * BM + wc * 32 + 4 * fq;
#pragma unroll
        for (int ai = 0; ai < 2; ++ai)
#pragma unroll
            for (int m = 0; m < 4; ++m) {
                const size_t off = (size_t)(row0 + ai * HALF + m * 16) * ldc + col0;
#pragma unroll
                for (int bj = 0; bj < 2; ++bj)
#pragma unroll
                    for (int n = 0; n < 2; ++n) {
                        const f32x4 r = *(const f32x4*)(res + off + bj * HALF + n * 16);
                        *(f32x4*)(out + off + bj * HALF + n * 16) = r * alpha + acc[ai][bj][m][n] * scale;
                    }
            }
    }
};
template <int MODE, long OFF1, long OFF2> struct EpiSplit {
    static constexpr bool PERM = true, AFTER_DRAIN = false;
    bf16_t* buf0; bf16_t* buf3; float* gates; const float* ib; const float* fb;
    __device__ __forceinline__ void operator()(const f32x4 (&acc)[2][2][4][2], const Unit& u, int wr, int wc, int fr, int fq) const {
        const int grp = u.pn >> 2, row0 = u.pm * BM + wr * 64 + fr;
        if (grp == 3) {
            if (MODE == 0) {
                if (wc == 0 && fq == 0) {
                    const f32x4 bi = *(const f32x4*)ib, bf = *(const f32x4*)fb;
#pragma unroll
                    for (int ai = 0; ai < 2; ++ai)
#pragma unroll
                        for (int m = 0; m < 4; ++m) {
                            float* g = gates + (size_t)(row0 + ai * HALF + m * 16) * 8;
                            const f32x4 vi = acc[ai][0][m][0] + bi; f32x4 vf = acc[ai][0][m][1] + bf;
#pragma unroll
                            for (int j = 0; j < 4; ++j) { const float x = vf[j]; vf[j] = fminf(x, 0.f) - log1pf(__expf(-fabsf(x))); }
                            *(f32x4*)g = vi; *(f32x4*)(g + 4) = vf;
                        }
                }
            } else if (MODE == 1) {
                const int col0 = wc * 32 + 8 * fq;
#pragma unroll
                for (int ai = 0; ai < 2; ++ai)
#pragma unroll
                    for (int m = 0; m < 4; ++m) { bf16_t* rowp = buf3 + (size_t)(row0 + ai * HALF + m * 16) * 256 + col0;
#pragma unroll
                        for (int bj = 0; bj < 2; ++bj) { const f32x4 v0 = acc[ai][bj][m][0], v1 = acc[ai][bj][m][1]; u32x4 w;
                            w.x = cvt_pk_bf16(v0[0], v0[1]); w.y = cvt_pk_bf16(v0[2], v0[3]); w.z = cvt_pk_bf16(v1[0], v1[1]); w.w = cvt_pk_bf16(v1[2], v1[3]);
                            *(u32x4*)(rowp + bj * HALF) = w; } }
            }
            return;
        }
        bf16_t* base = buf0 + (grp == 0 ? 0L : (grp == 1 ? OFF1 : OFF2));
        const int col0 = (u.pn & 3) * BM + wc * 32 + 8 * fq;
#pragma unroll
        for (int ai = 0; ai < 2; ++ai)
#pragma unroll
            for (int m = 0; m < 4; ++m) { bf16_t* rowp = base + (size_t)(row0 + ai * HALF + m * 16) * 1024 + col0;
#pragma unroll
                for (int bj = 0; bj < 2; ++bj) { f32x4 v0 = acc[ai][bj][m][0], v1 = acc[ai][bj][m][1];
                    if (MODE == 2) {
#pragma unroll
                        for (int j = 0; j < 4; ++j) { v0[j] = sigmoidf_(v0[j]); v1[j] = sigmoidf_(v1[j]); }
                        if (grp == 0) { const u32x4 o = *(const u32x4*)(rowp + bj * HALF);
                            v0[0] *= bf_lo(o.x); v0[1] *= bf_hi(o.x); v0[2] *= bf_lo(o.y); v0[3] *= bf_hi(o.y);
                            v1[0] *= bf_lo(o.z); v1[1] *= bf_hi(o.z); v1[2] *= bf_lo(o.w); v1[3] *= bf_hi(o.w); }
                    }
                    u32x4 w; w.x = cvt_pk_bf16(v0[0], v0[1]); w.y = cvt_pk_bf16(v0[2], v0[3]); w.z = cvt_pk_bf16(v1[0], v1[1]); w.w = cvt_pk_bf16(v1[2], v1[3]);
                    *(u32x4*)(rowp + bj * HALF) = w; } }
    }
};
template <bool SECOND> struct EpiBranch {
    static constexpr bool PERM = true, AFTER_DRAIN = false;
    bf16_t* G; const bf16_t* T1;
    __device__ __forceinline__ void operator()(const f32x4 (&acc)[2][2][4][2], const Unit& u, int wr, int wc, int fr, int fq) const {
        const int row0 = u.pm * BM + wr * 64 + fr, col0 = u.pn * BM + wc * 32 + 8 * fq;
#pragma unroll
        for (int ai = 0; ai < 2; ++ai)
#pragma unroll
            for (int m = 0; m < 4; ++m) { const size_t off = (size_t)(row0 + ai * HALF + m * 16) * 1024 + col0;
#pragma unroll
                for (int bj = 0; bj < 2; ++bj) { const f32x4 a0 = acc[ai][bj][m][0], a1 = acc[ai][bj][m][1];
                    const u32x4 g = *(const u32x4*)(G + off + bj * HALF);
                    float r[8] = { bf_lo(g.x) * a0[0], bf_hi(g.x) * a0[1], bf_lo(g.y) * a0[2], bf_hi(g.y) * a0[3], bf_lo(g.z) * a1[0], bf_hi(g.z) * a1[1], bf_lo(g.w) * a1[2], bf_hi(g.w) * a1[3] };
                    if (SECOND) { const u32x4 t = *(const u32x4*)(T1 + off + bj * HALF);
                        r[0] += bf_lo(t.x); r[1] += bf_hi(t.x); r[2] += bf_lo(t.y); r[3] += bf_hi(t.y); r[4] += bf_lo(t.z); r[5] += bf_hi(t.z); r[6] += bf_lo(t.w); r[7] += bf_hi(t.w); }
                    u32x4 w; w.x = cvt_pk_bf16(r[0], r[1]); w.y = cvt_pk_bf16(r[2], r[3]); w.z = cvt_pk_bf16(r[4], r[5]); w.w = cvt_pk_bf16(r[6], r[7]);
                    *(u32x4*)(G + off + bj * HALF) = w; } }
    }
};

template <class Epi, class Sched, bool ALIGN_EPI = false, bool SP2 = false>
__device__ __forceinline__ void gemm_phase(PG8_LAS unsigned char* lds, const Gemm g, const Sched& S, const Epi& E) {
    const int tid = threadIdx.x, wid = __builtin_amdgcn_readfirstlane(tid >> 6), lane = tid & 63, wr = wid >> 2, wc = wid & 3, fr = lane & 15, fq = lane >> 4;
    const int K = g.K, nt = K / BK;
    unsigned voffA[2], voffB[2];
#pragma unroll
    for (int i = 0; i < 2; ++i) { int R, C; stage_rc(tid * 16 + i * 8192, R, C); const int Rb = Epi::PERM ? ((R & ~31) + perm32(R & 31)) : R;
        voffA[i] = (unsigned)(R * K + C) * 2u; voffB[i] = (unsigned)(Rb * K + C) * 2u; }
    const size_t kstep = (size_t)(BK * 2);
    const size_t hstep = (size_t)HALF * K * 2;
    const size_t tstep = 2 * hstep;
    const unsigned ldsw = (unsigned)wid * 1024u;
    const int aoff = lds_byte(wr * 64 + fr, fq * 8), boff = lds_byte(wc * 32 + fr, fq * 8);
#define PG8_SA(b, h) (((b) * 2 + (h)) * HTB)
#define PG8_SB(b, h) ((4 + (b) * 2 + (h)) * HTB)
#define PG8_STAGE(bufoff, gbase, voff) do { _Pragma("unroll") for (int _i = 0; _i < 2; ++_i) \
        __builtin_amdgcn_global_load_lds((const unsigned*)((const char*)(gbase) + (voff)[_i]), (PG8_LAS unsigned*)(lds + (bufoff) + ldsw + _i * 8192), 16, 0, 0); } while (0)
#define PG8_LDA(dst, b, h) do { _Pragma("unroll") for (int m = 0; m < 4; ++m) _Pragma("unroll") for (int k = 0; k < 2; ++k) dst[m][k] = *(const PG8_LAS bf16x8*)(lds + PG8_SA(b, h) + aoff + m * 2048 + k * 1024); } while (0)
#define PG8_LDB(dst, b, h) do { _Pragma("unroll") for (int n = 0; n < 2; ++n) _Pragma("unroll") for (int k = 0; k < 2; ++k) dst[n][k] = *(const PG8_LAS bf16x8*)(lds + PG8_SB(b, h) + boff + n * 2048 + k * 1024); } while (0)
#define PG8_MMA(ai, bj, At, Bt) do { __builtin_amdgcn_s_setprio(1); _Pragma("unroll") for (int m = 0; m < 4; ++m) _Pragma("unroll") for (int n = 0; n < 2; ++n) _Pragma("unroll") for (int k = 0; k < 2; ++k) \
        acc[ai][bj][m][n] = __builtin_amdgcn_mfma_f32_16x16x32_bf16(Bt[n][k], At[m][k], acc[ai][bj][m][n], 0, 0, 0); __builtin_amdgcn_s_setprio(0); } while (0)
#define PG8_WAIT_V(n) asm volatile("s_waitcnt vmcnt(" #n ")" ::: "memory")
#define PG8_WAIT_L(n) asm volatile("s_waitcnt lgkmcnt(" #n ")" ::: "memory")
#define PG8_BAR __builtin_amdgcn_s_barrier()
#define PG8_SCHED __builtin_amdgcn_sched_barrier(0)
    Unit cur, nxt; int ui = 0;
    if (!S.next(0, cur)) return;
    f32x4 acc[2][2][4][2];
#pragma unroll
    for (int a = 0; a < 2; ++a)
#pragma unroll
        for (int b = 0; b < 2; ++b)
#pragma unroll
            for (int m = 0; m < 4; ++m)
#pragma unroll
                for (int n = 0; n < 2; ++n) acc[a][b][m][n] = (f32x4){0.f, 0.f, 0.f, 0.f};
    bf16x8 At[4][2], B0[2][2], B1[2][2];
    const char* cA = (const char*)g.A + (size_t)cur.pm * tstep; const char* cB = (const char*)g.Bt + (size_t)cur.pn * tstep;
    S.a_ready(cur);
    if constexpr (SP2) {
        PG8_STAGE(PG8_SB(0, 0), cB, voffB); PG8_STAGE(PG8_SB(0, 1), cB + hstep, voffB); PG8_STAGE(PG8_SA(0, 0), cA, voffA); PG8_STAGE(PG8_SA(0, 1), cA + hstep, voffA);
        if (wr == 1) PG8_BAR;
        PG8_WAIT_V(2); PG8_BAR;
        PG8_STAGE(PG8_SB(1, 0), cB + kstep, voffB); PG8_STAGE(PG8_SA(1, 0), cA + kstep, voffA); PG8_STAGE(PG8_SB(1, 1), cB + hstep + kstep, voffB);
        PG8_WAIT_V(6); PG8_BAR;
    } else {
        PG8_STAGE(PG8_SB(0, 0), cB, voffB); PG8_STAGE(PG8_SA(0, 0), cA, voffA); PG8_STAGE(PG8_SB(0, 1), cB + hstep, voffB); PG8_STAGE(PG8_SA(0, 1), cA + hstep, voffA);
        if (wr == 1) PG8_BAR;
        PG8_WAIT_V(4); PG8_BAR;
        PG8_STAGE(PG8_SB(1, 0), cB + kstep, voffB); PG8_STAGE(PG8_SA(1, 0), cA + kstep, voffA); PG8_STAGE(PG8_SB(1, 1), cB + hstep + kstep, voffB);
        PG8_WAIT_V(6); PG8_BAR;
    }
    for (;;) {
        const bool has_next = S.next(ui + 1, nxt);
        const char* nA = has_next ? (const char*)g.A + (size_t)nxt.pm * tstep : cA; const char* nB = has_next ? (const char*)g.Bt + (size_t)nxt.pn * tstep : cB;
        for (int t = 0; t < nt; t += 2) {
            const bool last = (t == nt - 2);
            const char* a1 = cA + (size_t)(t + 1) * kstep;
            const char* a2 = last ? nA : cA + (size_t)(t + 2) * kstep; const char* b2 = last ? nB : cB + (size_t)(t + 2) * kstep;
            const char* a3 = a2 + kstep; const char* b3 = b2 + kstep;
            if (last && has_next) S.a_ready(nxt);
            if constexpr (SP2) {
            PG8_LDB(B0, 0, 0); PG8_LDB(B1, 0, 1); PG8_SCHED; PG8_LDA(At, 0, 0); PG8_STAGE(PG8_SA(1, 1), a1 + hstep, voffA);
            PG8_WAIT_V(8); PG8_WAIT_L(0); PG8_BAR; PG8_MMA(0, 0, At, B0); PG8_MMA(0, 1, At, B1); PG8_BAR; PG8_SCHED;
            PG8_LDA(At, 0, 1); PG8_STAGE(PG8_SB(0, 0), b2, voffB); PG8_STAGE(PG8_SB(0, 1), b2 + hstep, voffB); PG8_STAGE(PG8_SA(0, 0), a2, voffA);
            PG8_WAIT_V(8); PG8_WAIT_L(0); PG8_BAR; PG8_MMA(1, 0, At, B0); PG8_MMA(1, 1, At, B1); PG8_BAR; PG8_SCHED;
            PG8_LDB(B0, 1, 0); PG8_LDB(B1, 1, 1); PG8_SCHED; PG8_LDA(At, 1, 0); PG8_STAGE(PG8_SA(0, 1), a2 + hstep, voffA);
            PG8_WAIT_V(8); PG8_WAIT_L(0); PG8_BAR; PG8_MMA(0, 0, At, B0); PG8_MMA(0, 1, At, B1); PG8_BAR; PG8_SCHED;
            PG8_LDA(At, 1, 1); PG8_STAGE(PG8_SB(1, 0), b3, voffB); PG8_STAGE(PG8_SB(1, 1), b3 + hstep, voffB); PG8_STAGE(PG8_SA(1, 0), a3, voffA);
            PG8_WAIT_V(8); PG8_WAIT_L(0); PG8_BAR; PG8_MMA(1, 0, At, B0); PG8_MMA(1, 1, At, B1); PG8_BAR; PG8_SCHED;
            } else {
            PG8_LDB(B0, 0, 0); PG8_SCHED; PG8_LDA(At, 0, 0); PG8_STAGE(PG8_SA(1, 1), a1 + hstep, voffA);
            PG8_WAIT_L(8); PG8_BAR; PG8_WAIT_L(0); PG8_MMA(0, 0, At, B0); PG8_BAR; PG8_SCHED;
            PG8_LDB(B1, 0, 1); PG8_STAGE(PG8_SB(0, 0), b2, voffB);
            PG8_BAR; PG8_WAIT_L(0); PG8_MMA(0, 1, At, B1); PG8_BAR;
            PG8_LDA(At, 0, 1); PG8_STAGE(PG8_SA(0, 0), a2, voffA);
            PG8_BAR; PG8_WAIT_L(0); PG8_MMA(1, 0, At, B0); PG8_BAR; PG8_SCHED;
            PG8_STAGE(PG8_SB(0, 1), b2 + hstep, voffB);
            PG8_WAIT_V(6); PG8_BAR; PG8_MMA(1, 1, At, B1); PG8_BAR;
            PG8_LDB(B0, 1, 0); PG8_SCHED; PG8_LDA(At, 1, 0); PG8_STAGE(PG8_SA(0, 1), a2 + hstep, voffA);
            PG8_WAIT_L(8); PG8_BAR; PG8_WAIT_L(0); PG8_MMA(0, 0, At, B0); PG8_BAR; PG8_SCHED;
            PG8_LDB(B1, 1, 1); PG8_STAGE(PG8_SB(1, 0), b3, voffB);
            PG8_BAR; PG8_WAIT_L(0); PG8_MMA(0, 1, At, B1); PG8_BAR;
            PG8_LDA(At, 1, 1); PG8_STAGE(PG8_SA(1, 0), a3, voffA);
            PG8_BAR; PG8_WAIT_L(0); PG8_MMA(1, 0, At, B0); PG8_BAR; PG8_SCHED;
            PG8_STAGE(PG8_SB(1, 1), b3 + hstep, voffB);
            PG8_WAIT_V(6); PG8_BAR; PG8_MMA(1, 1, At, B1); PG8_BAR;
            }
        }
        if constexpr (ALIGN_EPI) { if (wr == 0) PG8_BAR; }
        if constexpr (!Epi::AFTER_DRAIN) { E(acc, cur, wr, wc, fr, fq); S.done(cur); }
        if (!has_next) break;
#pragma unroll
        for (int a = 0; a < 2; ++a)
#pragma unroll
            for (int b = 0; b < 2; ++b)
#pragma unroll
                for (int m = 0; m < 4; ++m)
#pragma unroll
                    for (int n = 0; n < 2; ++n) acc[a][b][m][n] = (f32x4){0.f, 0.f, 0.f, 0.f};
        cur = nxt; cA = nA; cB = nB; ++ui;
        if constexpr (ALIGN_EPI) { if (wr == 1) PG8_BAR; }
    }
    PG8_WAIT_V(0);
    if constexpr (!ALIGN_EPI) { if (wr == 0) PG8_BAR; }
    PG8_BAR;
    if constexpr (Epi::AFTER_DRAIN) { E.fused(acc, cur, wr, wc, fr, fq, lds, wid, lane); S.done(cur); }
#undef PG8_SA
#undef PG8_SB
#undef PG8_STAGE
#undef PG8_LDA
#undef PG8_LDB
#undef PG8_MMA
#undef PG8_WAIT_V
#undef PG8_WAIT_L
#undef PG8_BAR
#undef PG8_SCHED
}
}

constexpr int NWAVES = 8, NTHR = 512;
constexpr int BATCH = 2, T = 8192, D = 1024, FF = 2816, M = BATCH * T;
constexpr int WIN_LD = 9480;
constexpr float ALPHA = 1.189207115002721f;
constexpr size_t MiB = 1u << 20;
constexpr size_t WS_GATES = 1 * MiB;
constexpr size_t WS_CT = WS_GATES + 512 * 1024;
constexpr size_t WS_NLOC = WS_CT + 1 * MiB;
constexpr size_t WS_GC = WS_NLOC + 512 * 1024;
constexpr size_t WS_W2T = WS_GC + 64 * 1024;
constexpr size_t WS_A2T = WS_W2T + 128 * 1024;
constexpr size_t WS_G2T = WS_A2T + 128 * 1024;
constexpr size_t WS_WIN1 = 4 * MiB;
constexpr size_t WS_WIN2 = WS_WIN1 + 6656 * 1024;
constexpr size_t WS_WIN3 = WS_WIN2 + 6656 * 1024;
constexpr size_t WS_WA = 23 * MiB, WS_WB = 25 * MiB, WS_WO = 27 * MiB;
constexpr size_t WS_WF = 29 * MiB;
constexpr size_t WS_WFD = 40 * MiB;
constexpr size_t WS_XB = 46 * MiB;
constexpr size_t WS_B = 78 * MiB, WS_C = 110 * MiB, WS_D = 142 * MiB, WS_E = 174 * MiB;
constexpr size_t WS_H = WS_B;
constexpr size_t WS_RV = WS_E, WS_LR = WS_E + 32 * MiB, WS_YR = WS_E + 40 * MiB;
constexpr size_t WS_END = WS_YR + 32 * MiB;
static_assert(WS_G2T + 256 * 1024 <= WS_WIN1 && WS_WIN3 + 6 * MiB <= WS_WA && WS_WFD + 5632 * 1024 <= WS_XB && WS_H + (size_t)M * FF * 2 <= WS_E && WS_END <= 256 * MiB, "ws map");
constexpr int LDS_BYTES = 147456;

#define LAS __attribute__((address_space(3)))
typedef unsigned short bf16;
typedef unsigned v4u __attribute__((ext_vector_type(4)));
typedef float f32x4 __attribute__((ext_vector_type(4)));
typedef float f32x16 __attribute__((ext_vector_type(16)));
typedef short bf16x8 __attribute__((ext_vector_type(8)));
__device__ __forceinline__ unsigned f2bf(float f) { unsigned u = __builtin_bit_cast(unsigned, f); return (u + 0x7fffu + ((u >> 16) & 1u)) >> 16; }
__device__ __forceinline__ unsigned pk2(float lo, float hi) { return pg8::cvt_pk_bf16(lo, hi); }
__device__ __forceinline__ float bfl(unsigned w) { return __uint_as_float(w << 16); }
__device__ __forceinline__ float bfh(unsigned w) { return __uint_as_float(w & 0xffff0000u); }
__device__ __forceinline__ float bf1(bf16 h) { return __uint_as_float((unsigned)h << 16); }
__device__ __forceinline__ void unpack8(const v4u w, float (&o)[8]) { o[0] = bfl(w.x); o[1] = bfh(w.x); o[2] = bfl(w.y); o[3] = bfh(w.y); o[4] = bfl(w.z); o[5] = bfh(w.z); o[6] = bfl(w.w); o[7] = bfh(w.w); }
__device__ __forceinline__ float sigm(float x) { return 1.0f / (1.0f + __expf(-x)); }
__device__ __forceinline__ float wave_sum(float v) {
#pragma unroll
    for (int o = 1; o < 64; o <<= 1) v += __shfl_xor(v, o);
    return v;
}
#define MFMA32(a, b, c) __builtin_amdgcn_mfma_f32_32x32x16_bf16(a, b, c, 0, 0, 0)

struct Ptrs {
    const float* x; const float *f1g, *f1u, *f1d, *ln1g, *ln1b, *win, *cw, *cb, *ib, *fb, *mng, *rmu, *rw0, *rw2, *ra0, *ra2, *rg2, *rkk, *rka, *rrk, *gng, *gnb, *wa, *wb, *wo, *ln2g, *ln2b, *f2g, *f2u, *f2d, *ln3g, *ln3b;
    float* out; unsigned char* ws;
};

__device__ __forceinline__ void tr_item(const float* W, int ldw, int K, int src_col0, int nvalid, bf16* WT, int dst_row0, int k0, LAS float* scr, int lane) {
    const int n_ = lane & 31;
#pragma unroll 8
    for (int i = 0; i < 32; ++i) { const int kk = 2 * i + (lane >> 5); scr[kk * 33 + n_] = (n_ < nvalid) ? W[(size_t)(k0 + kk) * ldw + src_col0 + n_] : 0.f; }
    asm volatile("s_waitcnt lgkmcnt(0)" ::: "memory");
    const int c = lane & 7;
#pragma unroll
    for (int j = 0; j < 4; ++j) { const int n = (lane >> 3) + 8 * j; const LAS float* s = scr + (8 * c) * 33 + n;
        v4u o; o.x = pk2(s[0 * 33], s[1 * 33]); o.y = pk2(s[2 * 33], s[3 * 33]); o.z = pk2(s[4 * 33], s[5 * 33]); o.w = pk2(s[6 * 33], s[7 * 33]);
        *(v4u*)(WT + (size_t)(dst_row0 + n) * K + k0 + 8 * c) = o; }
    asm volatile("s_waitcnt lgkmcnt(0)" ::: "memory");
}
template <int KIND> __device__ __forceinline__ void conv_mat(const float* W, const float* W2, int ldw, int K, bf16* WT, int nrows, LAS float* scr, int gw, int NGW, int lane) {
    const int nkb = K / 64, items = (nrows / 32) * nkb;
    for (int it = gw; it < items; it += NGW) {
        const int nb = it / nkb, kb = it % nkb, r0 = nb * 32; const float* src = W; int sc = r0, nv = 32;
        if (KIND == 1) { const int g = r0 >> 8, wi = r0 & 255; src = wi < 128 ? W : W2; sc = g * 128 + (wi & 127); }
        if (KIND == 2) { if (r0 < 3072) sc = r0; else if (r0 == 3072) { sc = 4096; nv = 8; } else { sc = 0; nv = 0; } }
        if (KIND == 3) sc = 4104 + r0;
        if (KIND == 4) sc = r0 < 1024 ? 3072 + r0 : 7432 + (r0 - 1024);
        tr_item(src, ldw, K, sc, nv, WT, r0, kb * 64, scr, lane);
    }
}
__device__ __forceinline__ void cvt_rows_bf16(const float* X, bf16* O, int gw, int NGW, int lane) {
    for (int m = gw; m < M; m += NGW) { const f32x4* xr = (const f32x4*)(X + (size_t)m * D) + lane; unsigned long long* o8 = (unsigned long long*)(O + (size_t)m * D) + lane;
#pragma unroll
        for (int j = 0; j < 4; ++j) { const f32x4 v = xr[64 * j]; o8[64 * j] = (unsigned long long)pk2(v.x, v.y) | ((unsigned long long)pk2(v.z, v.w) << 32); } }
}
__device__ __forceinline__ void ln_rows(const float* Y, const float* g, const float* b, float* outf, bf16* outb, int gw, int NGW, int lane) {
    f32x4 gv[4], bv[4];
#pragma unroll
    for (int j = 0; j < 4; ++j) { gv[j] = ((const f32x4*)g)[lane + 64 * j]; bv[j] = ((const f32x4*)b)[lane + 64 * j]; }
    for (int m = gw; m < M; m += NGW) {
        const f32x4* xr = (const f32x4*)(Y + (size_t)m * D) + lane;
        f32x4 v[4]; float s = 0.f;
#pragma unroll
        for (int j = 0; j < 4; ++j) { v[j] = xr[64 * j]; s += (v[j].x + v[j].y) + (v[j].z + v[j].w); }
        const float mean = wave_sum(s) * (1.f / D); float s2 = 0.f;
#pragma unroll
        for (int j = 0; j < 4; ++j) { v[j] = v[j] - mean; s2 += (v[j].x * v[j].x + v[j].y * v[j].y) + (v[j].z * v[j].z + v[j].w * v[j].w); }
        const float rstd = 1.f / sqrtf(wave_sum(s2) * (1.f / D) + 1e-5f);
        f32x4* of = (f32x4*)(outf + (size_t)m * D) + lane;
#pragma unroll
        for (int j = 0; j < 4; ++j) { v[j] = v[j] * rstd * gv[j] + bv[j]; of[64 * j] = v[j]; }
        if (outb) { unsigned long long* o8 = (unsigned long long*)(outb + (size_t)m * D) + lane;
#pragma unroll
            for (int j = 0; j < 4; ++j) o8[64 * j] = (unsigned long long)pk2(v[j].x, v[j].y) | ((unsigned long long)pk2(v[j].z, v[j].w) << 32); }
    }
}

__device__ __forceinline__ void conv8(const bf16* X, int row, int t, int col0, const float* cw, const float* cb, int cc0, float scale, float (&o)[8]) {
    float a[8];
#pragma unroll
    for (int j = 0; j < 8; ++j) a[j] = cb[cc0 + j];
#pragma unroll
    for (int tap = 0; tap < 4; ++tap) {
        const int dt = 3 - tap;
        if (t - dt >= 0) { float xv[8]; unpack8(*(const v4u*)(X + (size_t)(row - dt) * 1024 + col0), xv);
#pragma unroll
            for (int j = 0; j < 8; ++j) a[j] += xv[j] * cw[tap * 2048 + cc0 + j]; }
    }
#pragma unroll
    for (int j = 0; j < 8; ++j) o[j] = a[j] / (1.0f + __expf(-a[j])) * scale;
}
__device__ __forceinline__ void chunk_gates(const float* gates, int row0, int h, LAS float* tmp, LAS float* fbv, LAS float* iv, int tid) {
    if (tid < 128) { tmp[tid] = gates[(size_t)(row0 + tid) * 8 + 4 + h]; iv[tid] = gates[(size_t)(row0 + tid) * 8 + h]; }
    __syncthreads();
    if (tid < 128) { float s = 0.f; for (int j = 0; j <= tid; ++j) s += tmp[j]; fbv[tid] = s; }
    __syncthreads();
}
__device__ __forceinline__ void mlstm_passA(const Ptrs& P, LAS unsigned char* lds, int unit, int tid, int wave, int lane) {
    const bf16* MK = (const bf16*)(P.ws + WS_C); const bf16* MV = (const bf16*)(P.ws + WS_D); const float* gates = (const float*)(P.ws + WS_GATES);
    bf16* CB = (bf16*)(P.ws + WS_E) + (size_t)unit * 65536; float* NL = (float*)(P.ws + WS_NLOC) + unit * 256; float* GC = (float*)(P.ws + WS_GC);
    const int c = unit & 63, h = (unit >> 6) & 3, b = unit >> 8, row0 = b * T + c * 128;
    LAS bf16* VT = (LAS bf16*)lds; LAS bf16* KT = (LAS bf16*)(lds + 69632);
    LAS float* fbv = (LAS float*)(lds + 139264); LAS float* wa = fbv + 128; LAS float* tmp = wa + 128; LAS float* iv = tmp + 128;
    chunk_gates(gates, row0, h, tmp, fbv, iv, tid);
    const float G = fbv[127];
    if (tid < 128) wa[tid] = __expf(G - fbv[tid] + iv[tid]);
    __syncthreads();
    { const int s = tid & 127, g = tid >> 7; const float w_s = wa[s]; const int row = row0 + s, t = c * 128 + s;
#pragma unroll 2
      for (int i = 0; i < 8; ++i) { const int d0 = g * 64 + i * 8; float xv[8]; unpack8(*(const v4u*)(MV + (size_t)row * 1024 + h * 256 + d0), xv);
#pragma unroll
          for (int j = 0; j < 8; ++j) VT[(d0 + j) * 136 + s] = (bf16)f2bf(xv[j] * w_s);
          float kv[8]; conv8(MK, row, t, h * 256 + d0, P.cw, P.cb, 1024 + h * 256 + d0, 1.0f, kv);
#pragma unroll
          for (int j = 0; j < 8; ++j) KT[(d0 + j) * 136 + s] = (bf16)f2bf(kv[j]); } }
    __syncthreads();
    const int lr_ = lane & 31, lh = lane >> 5;
    if (tid < 256) { float s = 0.f; for (int j = 0; j < 128; ++j) s += bf1(KT[tid * 136 + j]) * wa[j]; NL[tid] = s; }
    if (tid == 0) GC[unit] = G;
    for (int hf = 0; hf < 2; ++hf) {
        f32x16 acc[4];
#pragma unroll
        for (int i = 0; i < 4; ++i)
#pragma unroll
            for (int j = 0; j < 16; ++j) acc[i][j] = 0.f;
#pragma unroll 2
        for (int ks = 0; ks < 8; ++ks) {
            const bf16x8 a = *(const LAS bf16x8*)(VT + (wave * 32 + lr_) * 136 + ks * 16 + 8 * lh);
#pragma unroll
            for (int nt = 0; nt < 4; ++nt) { const bf16x8 bb = *(const LAS bf16x8*)(KT + ((hf * 4 + nt) * 32 + lr_) * 136 + ks * 16 + 8 * lh); acc[nt] = MFMA32(a, bb, acc[nt]); }
        }
        bf16* cb0 = CB + (wave * 32 + 4 * lh) * 256 + hf * 128 + lr_;
#pragma unroll
        for (int nt = 0; nt < 4; ++nt)
#pragma unroll
            for (int r = 0; r < 16; ++r) cb0[((r & 3) + 8 * (r >> 2)) * 256 + nt * 32] = (bf16)f2bf(acc[nt][r]);
    }
    __syncthreads();
}
__device__ __forceinline__ void mlstm_passB(const Ptrs& P, int gtid, int gthreads) {
    bf16* CB = (bf16*)(P.ws + WS_E); float* NL = (float*)(P.ws + WS_NLOC); const float* GC = (const float*)(P.ws + WS_GC);
    for (int i = gtid; i < 8 * 16384; i += gthreads) {
        const int bh = i >> 14, e4 = i & 16383; float st[4] = {0.f, 0.f, 0.f, 0.f};
#pragma unroll 4
        for (int c = 0; c < 64; ++c) { unsigned long long* p = (unsigned long long*)(CB + ((size_t)(bh * 64 + c) * 65536 + e4 * 4)); const unsigned long long w = *p;
            const float dec = __expf(GC[bh * 64 + c]); const unsigned lo = (unsigned)w, hi = (unsigned)(w >> 32);
            *p = (unsigned long long)pk2(st[0], st[1]) | ((unsigned long long)pk2(st[2], st[3]) << 32);
            st[0] = st[0] * dec + bfl(lo); st[1] = st[1] * dec + bfh(lo); st[2] = st[2] * dec + bfl(hi); st[3] = st[3] * dec + bfh(hi); }
    }
    for (int i = gtid; i < 8 * 256; i += gthreads) { const int bh = i >> 8, d = i & 255; float st = 0.f;
        for (int c = 0; c < 64; ++c) { float* p = NL + (bh * 64 + c) * 256 + d; const float v = *p; *p = st; st = st * __expf(GC[bh * 64 + c]) + v; } }
}
__device__ __forceinline__ void mlstm_passC(const Ptrs& P, LAS unsigned char* lds, int unit, int tid, int wave, int lane) {
    asm volatile("" : "+v"(tid), "+v"(lane));
    const bf16* MQ = (const bf16*)(P.ws + WS_B); const bf16* MK = (const bf16*)(P.ws + WS_C); bf16* MV = (bf16*)(P.ws + WS_D); const float* gates = (const float*)(P.ws + WS_GATES);
    const bf16* CT = (const bf16*)(P.ws + WS_E) + (size_t)unit * 65536; const float* NP = (const float*)(P.ws + WS_NLOC) + unit * 256;
    const int c = unit & 63, h = (unit >> 6) & 3, b = unit >> 8, row0 = b * T + c * 128;
    LAS bf16* Q = (LAS bf16*)lds; LAS bf16* K = (LAS bf16*)(lds + 67584); LAS bf16* SS = K; LAS bf16* VT = (LAS bf16*)(lds + 67584 + 34816);
    LAS float* fbv = (LAS float*)(lds + 137216); LAS float* es = fbv + 128; LAS float* tmp = es + 128; LAS float* iv = tmp + 128; LAS float* npv = iv + 128; LAS float* den = npv + 256;
    LAS float* Hs = (LAS float*)lds;
    chunk_gates(gates, row0, h, tmp, fbv, iv, tid);
    if (tid < 128) es[tid] = __expf(iv[tid] - fbv[tid]);
    if (tid < 256) npv[tid] = NP[tid];
    { const int s = tid & 127, g = tid >> 7; const int row = row0 + s, t = c * 128 + s;
#pragma unroll 2
      for (int i = 0; i < 8; ++i) { const int d0 = g * 64 + i * 8; float qv[8], kv[8];
          conv8(MQ, row, t, h * 256 + d0, P.cw, P.cb, h * 256 + d0, 0.0625f, qv); conv8(MK, row, t, h * 256 + d0, P.cw, P.cb, 1024 + h * 256 + d0, 1.0f, kv);
          v4u wq, wk; wq.x = pk2(qv[0], qv[1]); wq.y = pk2(qv[2], qv[3]); wq.z = pk2(qv[4], qv[5]); wq.w = pk2(qv[6], qv[7]);
          wk.x = pk2(kv[0], kv[1]); wk.y = pk2(kv[2], kv[3]); wk.z = pk2(kv[4], kv[5]); wk.w = pk2(kv[6], kv[7]);
          *(LAS v4u*)(Q + s * 264 + d0) = wq; *(LAS v4u*)(K + s * 264 + d0) = wk; } }
    __syncthreads();
    const int lr_ = lane & 31, lh = lane >> 5, rt = wave >> 1, wp = wave & 1;
    {
        f32x16 sacc[2];
#pragma unroll
        for (int i = 0; i < 2; ++i)
#pragma unroll
            for (int j = 0; j < 16; ++j) sacc[i][j] = 0.f;
#pragma unroll 4
        for (int ks = 0; ks < 16; ++ks) {
            const bf16x8 a = *(const LAS bf16x8*)(Q + (rt * 32 + lr_) * 264 + ks * 16 + 8 * lh);
#pragma unroll
            for (int j = 0; j < 2; ++j) { const bf16x8 bb = *(const LAS bf16x8*)(K + ((wp * 2 + j) * 32 + lr_) * 264 + ks * 16 + 8 * lh); sacc[j] = MFMA32(a, bb, sacc[j]); }
        }
        __syncthreads();
#pragma unroll
        for (int j = 0; j < 2; ++j) { const int s = (wp * 2 + j) * 32 + lr_; const float e = es[s];
#pragma unroll
            for (int r = 0; r < 16; ++r) { const int t = rt * 32 + (r & 3) + 8 * (r >> 2) + 4 * lh; SS[t * 136 + s] = (bf16)f2bf(s <= t ? sacc[j][r] * e : 0.f); } }
    }
    f32x16 acc[2][2];
#pragma unroll
    for (int i = 0; i < 2; ++i)
#pragma unroll
        for (int j = 0; j < 2; ++j)
#pragma unroll
            for (int r = 0; r < 16; ++r) acc[i][j][r] = 0.f;
#pragma unroll 2
    for (int ks = 0; ks < 16; ++ks) {
        const bf16x8 a = *(const LAS bf16x8*)(Q + (rt * 32 + lr_) * 264 + ks * 16 + 8 * lh);
#pragma unroll
        for (int hv = 0; hv < 2; ++hv)
#pragma unroll
            for (int j = 0; j < 2; ++j) { const int v = hv * 128 + (wp * 2 + j) * 32 + lr_; const bf16x8 bb = *(const bf16x8*)(CT + (size_t)v * 256 + ks * 16 + 8 * lh); acc[hv][j] = MFMA32(a, bb, acc[hv][j]); }
    }
    for (int hv = 0; hv < 2; ++hv) {
        { const int s = tid & 127, g = tid >> 7; const int row = row0 + s;
#pragma unroll
          for (int i = 0; i < 4; ++i) { const int d0 = g * 32 + i * 8; float xv[8]; unpack8(*(const v4u*)(MV + (size_t)row * 1024 + h * 256 + hv * 128 + d0), xv);
#pragma unroll
              for (int j = 0; j < 8; ++j) VT[(d0 + j) * 136 + s] = (bf16)f2bf(xv[j]); } }
        __syncthreads();
        if (hv == 0 && tid < 128) { float s1 = 0.f; for (int j = 0; j < 128; ++j) s1 += bf1(SS[tid * 136 + j]); float s2 = 0.f; for (int j = 0; j < 256; ++j) s2 += bf1(Q[tid * 264 + j]) * npv[j]; den[tid] = s1 + s2; }
#pragma unroll 2
        for (int ks = 0; ks < 8; ++ks) {
            const bf16x8 a = *(const LAS bf16x8*)(SS + (rt * 32 + lr_) * 136 + ks * 16 + 8 * lh);
#pragma unroll
            for (int j = 0; j < 2; ++j) { const bf16x8 bb = *(const LAS bf16x8*)(VT + ((wp * 2 + j) * 32 + lr_) * 136 + ks * 16 + 8 * lh);
                if (hv == 0) acc[0][j] = MFMA32(a, bb, acc[0][j]); else acc[1][j] = MFMA32(a, bb, acc[1][j]); }
        }
        __syncthreads();
    }
    { LAS float* hs0 = Hs + (rt * 32 + 4 * lh) * 260 + wp * 64 + lr_;
#pragma unroll
      for (int r = 0; r < 16; ++r) { const int t = rt * 32 + (r & 3) + 8 * (r >> 2) + 4 * lh; const float eb = __expf(fbv[t]); const float sc = eb / fmaxf(fabsf(eb * den[t]), 1.0f);
#pragma unroll
          for (int hv = 0; hv < 2; ++hv)
#pragma unroll
              for (int j = 0; j < 2; ++j) hs0[((r & 3) + 8 * (r >> 2)) * 260 + hv * 128 + j * 32] = acc[hv][j][r] * sc; } }
    __syncthreads();
    for (int i = 0; i < 16; ++i) { const int t = wave * 16 + i; float x[4]; float s = 0.f;
#pragma unroll
        for (int j = 0; j < 4; ++j) { x[j] = Hs[t * 260 + lane + 64 * j]; s += x[j]; }
        const float mean = wave_sum(s) * (1.f / 256.f); float s2 = 0.f;
#pragma unroll
        for (int j = 0; j < 4; ++j) { x[j] -= mean; s2 += x[j] * x[j]; }
        const float rstd = 1.f / sqrtf(wave_sum(s2) * (1.f / 256.f) + 1e-5f);
#pragma unroll
        for (int j = 0; j < 4; ++j) { const int v = lane + 64 * j; MV[(size_t)(row0 + t) * 1024 + h * 256 + v] = (bf16)f2bf(x[j] * rstd * P.mng[h * 256 + v]); } }
    __syncthreads();
}

__device__ __forceinline__ float dpp_xor1(float x) { return __builtin_bit_cast(float, __builtin_amdgcn_update_dpp(0, __builtin_bit_cast(int, x), 0xB1, 0xF, 0xF, true)); }
__device__ __forceinline__ float dpp_xor2(float x) { return __builtin_bit_cast(float, __builtin_amdgcn_update_dpp(0, __builtin_bit_cast(int, x), 0x4E, 0xF, 0xF, true)); }
__device__ __forceinline__ float dpp_hmir(float x) { return __builtin_bit_cast(float, __builtin_amdgcn_update_dpp(0, __builtin_bit_cast(int, x), 0x141, 0xF, 0xF, true)); }
__device__ __forceinline__ float red8(float x) { x += dpp_xor1(x); x += dpp_xor2(x); x += dpp_hmir(x); return x; }
__device__ __forceinline__ void shift8(const bf16* X, int ld, int row, int t, int col0, const float* mu, float (&o)[8]) {
    float xc[8]; unpack8(*(const v4u*)(X + (size_t)row * ld + col0), xc);
    float xp[8];
    if (t > 0) unpack8(*(const v4u*)(X + (size_t)(row - 1) * ld + col0), xp); else {
#pragma unroll
        for (int j = 0; j < 8; ++j) xp[j] = 0.f; }
#pragma unroll
    for (int j = 0; j < 8; ++j) o[j] = xc[j] + (xp[j] - xc[j]) * mu[j];
}
__device__ __forceinline__ void rwkv_unit(const Ptrs& P, LAS unsigned char* lds, int unit, int tid, int wave, int lane) {
    const bf16* RR = (const bf16*)(P.ws + WS_B); const bf16* RK = (const bf16*)(P.ws + WS_C); const bf16* RV = (const bf16*)(P.ws + WS_RV); const bf16* LR = (const bf16*)(P.ws + WS_LR);
    bf16* YR = (bf16*)(P.ws + WS_YR); float* CTB = (float*)(P.ws + WS_CT);
    const bf16* W2T = (const bf16*)(P.ws + WS_W2T); const bf16* A2T = (const bf16*)(P.ws + WS_A2T);
    const int rg = unit & 7, h = (unit >> 3) & 15, b = unit >> 7;
    LAS float* Wd = (LAS float*)lds;
    LAS float* Aa = Wd + 4096;
    LAS float* Bb = Aa + 4096;
    LAS float* Kp = Bb + 4096;
    LAS float* RW = Kp + 4096;
    LAS float* AL = RW + 4096;
    LAS bf16* TW = (LAS bf16*)(AL + 4096);
    LAS bf16* TA = TW + 64 * 72;
    LAS float* Vv = (LAS float*)(TA + 64 * 72);
    LAS float* SC = Vv + 512;
    LAS float* YB = SC + 128;
    const int tok = tid >> 3, part = tid & 7, c0 = part * 8, hc = h * 64 + c0;
    float kkc[8], kac[8], rrk[8], mur[8], muk[8], muw[8], mua[8];
#pragma unroll
    for (int j = 0; j < 8; ++j) { kkc[j] = P.rkk[hc + j]; kac[j] = P.rka[hc + j]; rrk[j] = P.rrk[hc + j]; mur[j] = P.rmu[hc + j]; muk[j] = P.rmu[1024 + hc + j]; muw[j] = P.rmu[3072 + c0 + j]; mua[j] = P.rmu[3136 + c0 + j]; }
    float muv[8];
#pragma unroll
    for (int j = 0; j < 8; ++j) muv[j] = P.rmu[2048 + h * 64 + rg * 8 + j];
    float S[8];
#pragma unroll
    for (int j = 0; j < 8; ++j) S[j] = 0.f;
    const int lr_ = lane & 31, lh = lane >> 5;
    for (int ch = 0; ch < T / 64; ++ch) {
        const int t = ch * 64 + tok, row = b * T + t;
        float r8[8], k8[8];
        shift8(RR, 1024, row, t, hc, mur, r8); shift8(RK, 1024, row, t, hc, muk, k8);
        { float w8[8], a8[8]; shift8(LR, 256, row, t, c0, muw, w8); shift8(LR, 256, row, t, 64 + c0, mua, a8);
#pragma unroll
          for (int j = 0; j < 8; ++j) { const float e2 = __expf(2.f * w8[j]); w8[j] = 1.f - 2.f / (e2 + 1.f); }
          v4u pw, pa; pw.x = pk2(w8[0], w8[1]); pw.y = pk2(w8[2], w8[3]); pw.z = pk2(w8[4], w8[5]); pw.w = pk2(w8[6], w8[7]);
          pa.x = pk2(a8[0], a8[1]); pa.y = pk2(a8[2], a8[3]); pa.z = pk2(a8[4], a8[5]); pa.w = pk2(a8[6], a8[7]);
          *(LAS v4u*)(TW + tok * 72 + c0) = pw; *(LAS v4u*)(TA + tok * 72 + c0) = pa; }
        if (part == 0) { float v8[8]; shift8(RV, 1024, row, t, h * 64 + rg * 8, muv, v8);
#pragma unroll
            for (int j = 0; j < 8; ++j) Vv[tok * 8 + j] = v8[j]; }
        __syncthreads();
        {
            const int mat = wave >> 2, rt = (wave >> 1) & 1, ct = wave & 1; const LAS bf16* As = mat ? TA : TW; const bf16* Bg = (mat ? A2T : W2T) + (size_t)(h * 64 + ct * 32 + lr_) * 64;
            f32x16 acc;
#pragma unroll
            for (int j = 0; j < 16; ++j) acc[j] = 0.f;
#pragma unroll
            for (int ks = 0; ks < 4; ++ks) { const bf16x8 a = *(const LAS bf16x8*)(As + (rt * 32 + lr_) * 72 + ks * 16 + 8 * lh); const bf16x8 bb = *(const bf16x8*)(Bg + ks * 16 + 8 * lh); acc = MFMA32(a, bb, acc); }
            const int cc = ct * 32 + lr_; const float bias = mat ? P.ra0[h * 64 + cc] : P.rw0[h * 64 + cc];
#pragma unroll
            for (int r = 0; r < 16; ++r) { const int tk = rt * 32 + (r & 3) + 8 * (r >> 2) + 4 * lh; const float z = bias + acc[r];
                if (mat) AL[tk * 64 + cc] = sigm(z);
                else { const float sp = fmaxf(-z, 0.f) + log1pf(__expf(-fabsf(z))); Wd[tk * 64 + cc] = __expf(-__expf(-sp - 0.5f)); } }
        }
        __syncthreads();
        {
            float ss = 0.f, kkv[8];
#pragma unroll
            for (int j = 0; j < 8; ++j) { kkv[j] = k8[j] * kkc[j]; ss += kkv[j] * kkv[j]; }
            ss = red8(ss);
            const float inv = 1.0f / fmaxf(sqrtf(ss), 1e-12f);
            float br = 0.f, kr = 0.f, cs = 0.f;
#pragma unroll
            for (int j = 0; j < 8; ++j) { const float al = AL[tok * 64 + c0 + j], w = Wd[tok * 64 + c0 + j], kk = kkv[j] * inv, kp = k8[j] * (1.f + (al - 1.f) * kac[j]), bb = kk * al;
                Aa[tok * 64 + c0 + j] = -kk; Bb[tok * 64 + c0 + j] = bb; Kp[tok * 64 + c0 + j] = kp; RW[tok * 64 + c0 + j] = r8[j] * w;
                br += bb * r8[j]; kr += kp * r8[j]; cs += r8[j] * kp * rrk[j]; }
            br = red8(br); kr = red8(kr); cs = red8(cs);
            if (part == 0) { SC[tok * 2] = br; SC[tok * 2 + 1] = kr; if (rg == 0) CTB[(size_t)row * 16 + h] = cs; }
        }
        __syncthreads();
        if (wave == 0) {
            const int rl = lane >> 3, q = lane & 7;
            for (int tk = 0; tk < 64; ++tk) {
                const f32x4 a0 = *(const LAS f32x4*)(Aa + tk * 64 + q * 8), a1 = *(const LAS f32x4*)(Aa + tk * 64 + q * 8 + 4);
                const f32x4 y0 = *(const LAS f32x4*)(RW + tk * 64 + q * 8), y1 = *(const LAS f32x4*)(RW + tk * 64 + q * 8 + 4);
                const f32x4 w0 = *(const LAS f32x4*)(Wd + tk * 64 + q * 8), w1 = *(const LAS f32x4*)(Wd + tk * 64 + q * 8 + 4);
                const f32x4 b0 = *(const LAS f32x4*)(Bb + tk * 64 + q * 8), b1 = *(const LAS f32x4*)(Bb + tk * 64 + q * 8 + 4);
                const f32x4 k0 = *(const LAS f32x4*)(Kp + tk * 64 + q * 8), k1 = *(const LAS f32x4*)(Kp + tk * 64 + q * 8 + 4);
                const float vv = Vv[tk * 8 + rl], brr = SC[tk * 2], krr = SC[tk * 2 + 1];
                float psa = 0.f, py = 0.f;
#pragma unroll
                for (int j = 0; j < 4; ++j) { psa += S[j] * a0[j] + S[4 + j] * a1[j]; py += S[j] * y0[j] + S[4 + j] * y1[j]; }
                psa = red8(psa); py = red8(py);
                const float y = py + psa * brr + vv * krr;
#pragma unroll
                for (int j = 0; j < 4; ++j) { S[j] = S[j] * w0[j] + (psa * b0[j] + vv * k0[j]); S[4 + j] = S[4 + j] * w1[j] + (psa * b1[j] + vv * k1[j]); }
                if (q == 0) YB[tk * 8 + rl] = y;
            }
        }
        __syncthreads();
        if (tid < 64) { v4u o; o.x = pk2(YB[tid * 8 + 0], YB[tid * 8 + 1]); o.y = pk2(YB[tid * 8 + 2], YB[tid * 8 + 3]); o.z = pk2(YB[tid * 8 + 4], YB[tid * 8 + 5]); o.w = pk2(YB[tid * 8 + 6], YB[tid * 8 + 7]);
            *(v4u*)(YR + (size_t)(b * T + ch * 64 + tid) * 1024 + h * 64 + rg * 8) = o; }
    }
}
__device__ __forceinline__ void rwkv_post(const Ptrs& P, LAS unsigned char* lds, int tile, int tid, int wave, int lane) {
    const bf16* RV = (const bf16*)(P.ws + WS_RV); const bf16* LR = (const bf16*)(P.ws + WS_LR); bf16* YR = (bf16*)(P.ws + WS_YR); const float* CTB = (const float*)(P.ws + WS_CT);
    const bf16* G2T = (const bf16*)(P.ws + WS_G2T);
    LAS bf16* SG = (LAS bf16*)lds;
    LAS float* ST = (LAS float*)(lds + 64 * 136 * 2);
    const int tok = tid >> 3, part = tid & 7, row = tile * 64 + tok, t = row & (T - 1);
#pragma unroll
    for (int i = 0; i < 2; ++i) { const int c0 = part * 16 + i * 8; float mu[8], g8[8];
#pragma unroll
        for (int j = 0; j < 8; ++j) mu[j] = P.rmu[3200 + c0 + j];
        shift8(LR, 256, row, t, 128 + c0, mu, g8);
        v4u pg; pg.x = pk2(sigm(g8[0]), sigm(g8[1])); pg.y = pk2(sigm(g8[2]), sigm(g8[3])); pg.z = pk2(sigm(g8[4]), sigm(g8[5])); pg.w = pk2(sigm(g8[6]), sigm(g8[7]));
        *(LAS v4u*)(SG + tok * 136 + c0) = pg; }
#pragma unroll
    for (int i = 0; i < 2; ++i) { const int hd = part * 2 + i; float s = 0.f, s2 = 0.f;
#pragma unroll
        for (int k = 0; k < 8; ++k) { float x8[8]; unpack8(*(const v4u*)(YR + (size_t)row * 1024 + hd * 64 + k * 8), x8);
#pragma unroll
            for (int j = 0; j < 8; ++j) { s += x8[j]; s2 += x8[j] * x8[j]; } }
        const float mean = s * (1.f / 64.f); const float var = fmaxf(s2 * (1.f / 64.f) - mean * mean, 0.f);
        ST[(tok * 16 + hd) * 2] = mean; ST[(tok * 16 + hd) * 2 + 1] = 1.f / sqrtf(var + 64e-5f); }
    __syncthreads();
    const int lr_ = lane & 31, lh = lane >> 5;
    for (int hf = 0; hf < 2; ++hf) {
        f32x16 acc[2][2];
#pragma unroll
        for (int i = 0; i < 2; ++i)
#pragma unroll
            for (int j = 0; j < 2; ++j)
#pragma unroll
                for (int r = 0; r < 16; ++r) acc[i][j][r] = 0.f;
        const int cbase = wave * 128 + hf * 64;
#pragma unroll 2
        for (int ks = 0; ks < 8; ++ks) {
            bf16x8 a[2];
#pragma unroll
            for (int i = 0; i < 2; ++i) a[i] = *(const LAS bf16x8*)(SG + (i * 32 + lr_) * 136 + ks * 16 + 8 * lh);
#pragma unroll
            for (int j = 0; j < 2; ++j) { const bf16x8 bb = *(const bf16x8*)(G2T + (size_t)(cbase + j * 32 + lr_) * 128 + ks * 16 + 8 * lh);
#pragma unroll
                for (int i = 0; i < 2; ++i) acc[i][j] = MFMA32(a[i], bb, acc[i][j]); }
        }
        LAS bf16* GL = (LAS bf16*)(lds + 32768) + wave * (64 * 72);
#pragma unroll
        for (int j = 0; j < 2; ++j)
#pragma unroll
            for (int i = 0; i < 2; ++i)
#pragma unroll
                for (int r = 0; r < 16; ++r) GL[(i * 32 + (r & 3) + 8 * (r >> 2) + 4 * lh) * 72 + j * 32 + lr_] = (bf16)f2bf(acc[i][j][r]);
        asm volatile("s_waitcnt lgkmcnt(0)" ::: "memory");
        const int c8 = (lane & 7) * 8, chn0 = cbase + c8, hd = chn0 >> 6;
        float gg[8], gb[8], muv[8];
#pragma unroll
        for (int j = 0; j < 8; ++j) { gg[j] = P.gng[chn0 + j]; gb[j] = P.gnb[chn0 + j]; muv[j] = P.rmu[2048 + chn0 + j]; }
#pragma unroll 1
        for (int p = 0; p < 8; ++p) { const int tk = p * 8 + (lane >> 3), rw_ = tile * 64 + tk, tt = rw_ & (T - 1);
            float y8[8], v8[8], g8[8]; unpack8(*(const v4u*)(YR + (size_t)rw_ * 1024 + chn0), y8); shift8(RV, 1024, rw_, tt, chn0, muv, v8); unpack8(*(const LAS v4u*)(GL + tk * 72 + c8), g8);
            const float mean = ST[(tk * 16 + hd) * 2], rstd = ST[(tk * 16 + hd) * 2 + 1], ctv = CTB[(size_t)rw_ * 16 + hd];
            float o[8];
#pragma unroll
            for (int j = 0; j < 8; ++j) o[j] = (((y8[j] - mean) * rstd * gg[j] + gb[j]) + ctv * v8[j]) * g8[j];
            v4u w; w.x = pk2(o[0], o[1]); w.y = pk2(o[2], o[3]); w.z = pk2(o[4], o[5]); w.w = pk2(o[6], o[7]);
            *(v4u*)(YR + (size_t)rw_ * 1024 + chn0) = w; }
        asm volatile("s_waitcnt lgkmcnt(0)" ::: "memory");
    }
    __syncthreads();
}

struct Args { Ptrs p; int ph_lo, ph_hi, coop, pad; };
constexpr int N_PHASES = 18;
__global__ void __launch_bounds__(NTHR, 2) mk_fwd(Args args) {
    extern __shared__ __attribute__((aligned(16))) unsigned char lds_raw[];
    LAS unsigned char* lds = (LAS unsigned char*)lds_raw;
    const Ptrs& P = args.p;
    const int tid = threadIdx.x, lane = tid & 63, wave = __builtin_amdgcn_readfirstlane(tid >> 6);
    const int G = gridDim.x, bx = blockIdx.x, gw = bx * NWAVES + wave, NGW = G * NWAVES;
    unsigned char* ws = P.ws;
    bf16* XB = (bf16*)(ws + WS_XB); bf16* HB = (bf16*)(ws + WS_H);
    bf16* BB = (bf16*)(ws + WS_B); bf16* CBf = (bf16*)(ws + WS_C); bf16* DB = (bf16*)(ws + WS_D);
    const int lo = args.ph_lo, hi = args.ph_hi;
#ifndef PH_MASK
#define PH_MASK 0x3FFFF
#endif
#define IN(k) ((((PH_MASK) >> (k)) & 1) && lo <= (k) && (k) < hi)
#define SEAM(k) do { if (IN(k) && IN((k) + 1)) { cg::this_grid().sync(); } } while (0)
    LAS float* scr = (LAS float*)(lds + wave * 16384);

    if (IN(0)) {
        conv_mat<1>(P.f1g, P.f1u, FF, D, (bf16*)(ws + WS_WF), 5632, scr, gw, NGW, lane);
        conv_mat<0>(P.f1d, nullptr, D, FF, (bf16*)(ws + WS_WFD), 1024, scr, gw, NGW, lane);
        conv_mat<2>(P.win, nullptr, WIN_LD, D, (bf16*)(ws + WS_WIN1), 3328, scr, gw, NGW, lane);
        conv_mat<3>(P.win, nullptr, WIN_LD, D, (bf16*)(ws + WS_WIN2), 3328, scr, gw, NGW, lane);
        conv_mat<4>(P.win, nullptr, WIN_LD, D, (bf16*)(ws + WS_WIN3), 3072, scr, gw, NGW, lane);
        conv_mat<0>(P.wa, nullptr, D, D, (bf16*)(ws + WS_WA), 1024, scr, gw, NGW, lane);
        conv_mat<0>(P.wb, nullptr, D, D, (bf16*)(ws + WS_WB), 1024, scr, gw, NGW, lane);
        conv_mat<0>(P.wo, nullptr, D, D, (bf16*)(ws + WS_WO), 1024, scr, gw, NGW, lane);
        conv_mat<0>(P.rw2, nullptr, D, 64, (bf16*)(ws + WS_W2T), 1024, scr, gw, NGW, lane);
        conv_mat<0>(P.ra2, nullptr, D, 64, (bf16*)(ws + WS_A2T), 1024, scr, gw, NGW, lane);
        conv_mat<0>(P.rg2, nullptr, D, 128, (bf16*)(ws + WS_G2T), 1024, scr, gw, NGW, lane);
        cvt_rows_bf16(P.x, XB, gw, NGW, lane);
    }
    SEAM(0);
    if (IN(1)) { pg8::Gemm g{XB, (const bf16*)(ws + WS_WF), M, 5632, D}; pg8::StaticOrder S; S.init(M, 5632, G, bx); pg8::EpiSwiGLU E{HB, FF};
        pg8::gemm_phase<pg8::EpiSwiGLU, pg8::StaticOrder, true, true>(lds, g, S, E); }
    SEAM(1);
    if (IN(2)) { pg8::Gemm g{HB, (const bf16*)(ws + WS_WFD), M, D, FF}; pg8::StaticOrder S; S.init(M, D, G, bx); pg8::EpiResid E{P.x, P.out, D, ALPHA, 0.5f};
        pg8::gemm_phase<pg8::EpiResid, pg8::StaticOrder, true, true>(lds, g, S, E); }
    SEAM(2);
    if (IN(3)) {
        ln_rows(P.out, P.ln1g, P.ln1b, P.out, XB, gw, NGW, lane);
        conv_mat<1>(P.f2g, P.f2u, FF, D, (bf16*)(ws + WS_WF), 5632, scr, gw, NGW, lane);
        conv_mat<0>(P.f2d, nullptr, D, FF, (bf16*)(ws + WS_WFD), 1024, scr, gw, NGW, lane);
    }
    SEAM(3);
    if (IN(4)) { pg8::Gemm g{XB, (const bf16*)(ws + WS_WIN1), M, 3328, D}; pg8::StaticOrder S; S.init(M, 3328, G, bx);
        typedef pg8::EpiSplit<0, (long)(WS_C - WS_B) / 2, (long)(WS_D - WS_B) / 2> EP; EP E{BB, nullptr, (float*)(ws + WS_GATES), P.ib, P.fb};
        pg8::gemm_phase<EP, pg8::StaticOrder, true, true>(lds, g, S, E); }
    SEAM(4);
    if (IN(5)) { for (int u = bx; u < 512; u += G) mlstm_passA(P, lds, u, tid, wave, lane); }
    SEAM(5);
    if (IN(6)) { mlstm_passB(P, bx * NTHR + tid, G * NTHR); }
    SEAM(6);
    if (IN(7)) { for (int u = bx; u < 512; u += G) mlstm_passC(P, lds, u, tid, wave, lane); }
    SEAM(7);
    if (IN(8)) { pg8::Gemm g{XB, (const bf16*)(ws + WS_WIN2), M, 3328, D}; pg8::StaticOrder S; S.init(M, 3328, G, bx);
        typedef pg8::EpiSplit<1, (long)(WS_C - WS_B) / 2, (long)(WS_RV - WS_B) / 2> EP; EP E{BB, (bf16*)(ws + WS_LR), nullptr, nullptr, nullptr};
        pg8::gemm_phase<EP, pg8::StaticOrder, true, true>(lds, g, S, E); }
    SEAM(8);
    if (IN(9)) { for (int u = bx; u < 256; u += G) rwkv_unit(P, lds, u, tid, wave, lane); }
    SEAM(9);
    if (IN(10)) { for (int u = bx; u < M / 64; u += G) rwkv_post(P, lds, u, tid, wave, lane); }
    SEAM(10);
    if (IN(11)) { pg8::Gemm g{XB, (const bf16*)(ws + WS_WIN3), M, 3072, D}; pg8::StaticOrder S; S.init(M, 3072, G, bx);
        typedef pg8::EpiSplit<2, -(long)(WS_D - WS_C) / 2, -(long)(WS_D - WS_B) / 2> EP; EP E{DB, nullptr, nullptr, nullptr, nullptr};
        pg8::gemm_phase<EP, pg8::StaticOrder, true, true>(lds, g, S, E); }
    SEAM(11);
    if (IN(12)) {
        { pg8::Gemm g{DB, (const bf16*)(ws + WS_WA), M, D, D}; pg8::StaticOrder S; S.init(M, D, G, bx); pg8::EpiBranch<false> E{CBf, nullptr};
          pg8::gemm_phase<pg8::EpiBranch<false>, pg8::StaticOrder, true, true>(lds, g, S, E); }
        __syncthreads();
        { pg8::Gemm g{(const bf16*)(ws + WS_YR), (const bf16*)(ws + WS_WB), M, D, D}; pg8::StaticOrder S; S.init(M, D, G, bx); pg8::EpiBranch<true> E{BB, CBf};
          pg8::gemm_phase<pg8::EpiBranch<true>, pg8::StaticOrder, true, true>(lds, g, S, E); }
    }
    SEAM(12);
    if (IN(13)) { pg8::Gemm g{BB, (const bf16*)(ws + WS_WO), M, D, D}; pg8::StaticOrder S; S.init(M, D, G, bx); pg8::EpiResid E{P.out, P.out, D, ALPHA, 1.0f};
        pg8::gemm_phase<pg8::EpiResid, pg8::StaticOrder, true, true>(lds, g, S, E); }
    SEAM(13);
    if (IN(14)) { ln_rows(P.out, P.ln2g, P.ln2b, P.out, XB, gw, NGW, lane); }
    SEAM(14);
    if (IN(15)) { pg8::Gemm g{XB, (const bf16*)(ws + WS_WF), M, 5632, D}; pg8::StaticOrder S; S.init(M, 5632, G, bx); pg8::EpiSwiGLU E{HB, FF};
        pg8::gemm_phase<pg8::EpiSwiGLU, pg8::StaticOrder, true, true>(lds, g, S, E); }
    SEAM(15);
    if (IN(16)) { pg8::Gemm g{HB, (const bf16*)(ws + WS_WFD), M, D, FF}; pg8::StaticOrder S; S.init(M, D, G, bx); pg8::EpiResid E{P.out, P.out, D, ALPHA, 0.5f};
        pg8::gemm_phase<pg8::EpiResid, pg8::StaticOrder, true, true>(lds, g, S, E); }
    SEAM(16);
    if (IN(17)) { ln_rows(P.out, P.ln3g, P.ln3b, P.out, nullptr, gw, NGW, lane); }
#undef IN
#undef SEAM
}

#ifndef MK_N_LAUNCHES
#define MK_N_LAUNCHES 1
#endif
extern "C" void kernel_launch(void* const* d_in, const int* in_sizes, int n_in, void* d_out, int out_size, void* d_ws, size_t ws_size, hipStream_t stream) {
    static int grid = 0;
    if (grid == 0) {
        int dev = 0, cus = 0, per_cu = 0;
        hipGetDevice(&dev); hipDeviceGetAttribute(&cus, hipDeviceAttributeMultiprocessorCount, dev);
        hipFuncSetAttribute((const void*)mk_fwd, hipFuncAttributeMaxDynamicSharedMemorySize, LDS_BYTES);
        hipOccupancyMaxActiveBlocksPerMultiprocessor(&per_cu, (const void*)mk_fwd, NTHR, LDS_BYTES);
        if (per_cu < 1) { fprintf(stderr, "kernel_launch: occupancy query reports %d blocks per CU\n", per_cu); per_cu = 1; }
        grid = cus;
        if (n_in != 33 || ws_size < WS_END) fprintf(stderr, "kernel_launch: unexpected n_in %d / ws_size %zu\n", n_in, ws_size);
        (void)hipGetLastError();
    }
    Args a{};
    const float** pp = (const float**)&a.p;
    for (int i = 0; i < 33; ++i) pp[i] = (const float*)d_in[i];
    a.p.out = (float*)d_out; a.p.ws = (unsigned char*)d_ws;
    if (MK_N_LAUNCHES == 1) {
        a.ph_lo = 0; a.ph_hi = N_PHASES; a.coop = 1;
        void* kargs[] = {&a};
        hipError_t e = hipLaunchCooperativeKernel((const void*)mk_fwd, dim3(grid), dim3(NTHR), kargs, LDS_BYTES, stream);
        if (e != hipSuccess) fprintf(stderr, "cooperative launch failed: %s (grid %d)\n", hipGetErrorString(e), grid);
    } else {
        for (int ph = 0; ph < N_PHASES; ++ph) { a.ph_lo = ph; a.ph_hi = ph + 1; a.coop = 0; hipLaunchKernelGGL(mk_fwd, dim3(grid), dim3(NTHR), LDS_BYTES, stream, a); }
    }
}
```

```cpp
#include <hip/hip_runtime.h>
#include <hip/hip_cooperative_groups.h>
#include <cstdio>
#include <cstdint>
namespace cg = cooperative_groups;
namespace pg8 {
#define PG8_LAS __attribute__((address_space(3)))
typedef unsigned short bf16_t;
typedef short bf16x8 __attribute__((ext_vector_type(8)));
typedef float f32x4 __attribute__((ext_vector_type(4)));
typedef unsigned u32x4 __attribute__((ext_vector_type(4)));
constexpr int BM = 256, BK = 64, HALF = 128, HTB = HALF * BK * 2  , STAGE_BYTES = 8 * HTB, NXCD = 8, WGM = 8;

__host__ __device__ __forceinline__ int lds_byte(int r, int c) { const int st = (r >> 4) * 2 + (c >> 5), rr = r & 15, cc = c & 31, ob = rr * 64 + cc * 2; return st * 1024 + (ob ^ (((ob >> 9) & 1) << 5)); }
__host__ __device__ __forceinline__ void stage_rc(int b, int& R, int& C) { const int st = b / 1024, sb = b % 1024, swz = sb ^ (((sb >> 9) & 1) << 5); R = (st >> 1) * 16 + swz / 64; C = (st & 1) * 32 + (swz % 64) / 2; }
__host__ __device__ __forceinline__ int perm32(int rho) { const int n = rho >> 4, i = rho & 15; return 8 * (i >> 2) + 4 * n + (i & 3); }

struct Unit { int pm, pn; };
struct Gemm { const bf16_t* A; const bf16_t* Bt; int M, N, K; };

struct StaticOrder {
    int nM, nN, nwg, G, c;
    __host__ __device__ void init(int M, int N, int G_, int c_) { nM = M / BM; nN = N / BM; nwg = nM * nN; G = G_; c = c_; }
    __host__ __device__ bool next(int i, Unit& u) const {
        const long L = (long)i * G + c; if (L >= nwg) return false;
        int wgid = (int)L; { const int q = nwg / NXCD, r = nwg % NXCD, xcd = wgid % NXCD, off = wgid / NXCD; wgid = (xcd < r ? xcd * (q + 1) : r * (q + 1) + (xcd - r) * q) + off; }
        const int nig = WGM * nN, gid = wgid / nig, fm = gid * WGM, gsz = (nM - fm) < WGM ? (nM - fm) : WGM;
        u.pm = fm + ((wgid % nig) % gsz); u.pn = (wgid % nig) / gsz; return true;
    }
    __device__ __forceinline__ void a_ready(const Unit&) const {}
    __device__ __forceinline__ void done(const Unit&) const {}
};

__device__ __forceinline__ unsigned cvt_pk_bf16(float lo, float hi) { unsigned r; asm volatile("v_cvt_pk_bf16_f32 %0, %1, %2" : "=v"(r) : "v"(lo), "v"(hi)); return r; }
__device__ __forceinline__ float bf_lo(unsigned w) { return __uint_as_float(w << 16); }
__device__ __forceinline__ float bf_hi(unsigned w) { return __uint_as_float(w & 0xffff0000u); }
__device__ __forceinline__ float sigmoidf_(float x) { return 1.0f / (1.0f + __expf(-x)); }
__device__ __forceinline__ float siluf_(float x) { return x / (1.0f + __expf(-x)); }

struct EpiSwiGLU {
    static constexpr bool PERM = true, AFTER_DRAIN = false;
    bf16_t* H; int ldh;
    __device__ __forceinline__ void operator()(const f32x4 (&acc)[2][2][4][2], const Unit& u, int wr, int wc, int fr, int fq) const {
        const int row0 = u.pm * BM + wr * 64 + fr, col0 = u.pn * 128 + wc * 32 + 8 * fq;
#pragma unroll
        for (int ai = 0; ai < 2; ++ai)
#pragma unroll
            for (int m = 0; m < 4; ++m) {
                bf16_t* rowp = H + (size_t)(row0 + ai * HALF + m * 16) * ldh + col0;
                const f32x4 g0 = acc[ai][0][m][0], g1 = acc[ai][0][m][1], u0 = acc[ai][1][m][0], u1 = acc[ai][1][m][1];
                u32x4 w;
                w.x = cvt_pk_bf16(siluf_(g0[0]) * u0[0], siluf_(g0[1]) * u0[1]); w.y = cvt_pk_bf16(siluf_(g0[2]) * u0[2], siluf_(g0[3]) * u0[3]);
                w.z = cvt_pk_bf16(siluf_(g1[0]) * u1[0], siluf_(g1[1]) * u1[1]); w.w = cvt_pk_bf16(siluf_(g1[2]) * u1[2], siluf_(g1[3]) * u1[3]);
                *(u32x4*)rowp = w;
            }
    }
};
struct EpiResid {
    static constexpr bool PERM = false, AFTER_DRAIN = false;
    const float* res; float* out; int ldc; float alpha, scale;
    __device__ __forceinline__ void operator()(const f32x4 (&acc)[2][2][4][2], const Unit& u, int wr, int wc, int fr, int fq) const {
        const int row0 = u.pm * BM + wr * 64 + fr, col0 = u.pn * BM + wc * 32 + 4 * fq;
#pragma unroll
        for (int ai = 0; ai < 2; ++ai)
#pragma unroll
            for (int m = 0; m < 4; ++m) {
                const size_t off = (size_t)(row0 + ai * HALF + m * 16) * ldc + col0;
#pragma unroll
                for (int bj = 0; bj < 2; ++bj)
#pragma unroll
                    for (int n = 0; n < 2; ++n) {
                        const f32x4 r = *(const f32x4*)(res + off + bj * HALF + n * 16);
                        *(f32x4*)(out + off + bj * HALF + n * 16) = r * alpha + acc[ai][bj][m][n] * scale;
                    }
            }
    }
};
template <int MODE, long OFF1, long OFF2> struct EpiSplit {
    static constexpr bool PERM = true, AFTER_DRAIN = false;
    bf16_t* buf0; bf16_t* buf3; float* gates; const float* ib; const float* fb;
    __device__ __forceinline__ void operator()(const f32x4 (&acc)[2][2][4][2], const Unit& u, int wr, int wc, int fr, int fq) const {
        const int grp = u.pn >> 2, row0 = u.pm * BM + wr * 64 + fr;
        if (grp == 3) {
            if (MODE == 0) {
                if (wc == 0 && fq == 0) {
                    const f32x4 bi = *(const f32x4*)ib, bf = *(const f32x4*)fb;
#pragma unroll
                    for (int ai = 0; ai < 2; ++ai)
#pragma unroll
                        for (int m = 0; m < 4; ++m) {
                            float* g = gates + (size_t)(row0 + ai * HALF + m * 16) * 8;
                            const f32x4 vi = acc[ai][0][m][0] + bi; f32x4 vf = acc[ai][0][m][1] + bf;
#pragma unroll
                            for (int j = 0; j < 4; ++j) { const float x = vf[j]; vf[j] = fminf(x, 0.f) - log1pf(__expf(-fabsf(x))); }
                            *(f32x4*)g = vi; *(f32x4*)(g + 4) = vf;
                        }
                }
            } else if (MODE == 1) {
                const int col0 = wc * 32 + 8 * fq;
#pragma unroll
                for (int ai = 0; ai < 2; ++ai)
#pragma unroll
                    for (int m = 0; m < 4; ++m) { bf16_t* rowp = buf3 + (size_t)(row0 + ai * HALF + m * 16) * 256 + col0;
#pragma unroll
                        for (int bj = 0; bj < 2; ++bj) { const f32x4 v0 = acc[ai][bj][m][0], v1 = acc[ai][bj][m][1]; u32x4 w;
                            w.x = cvt_pk_bf16(v0[0], v0[1]); w.y = cvt_pk_bf16(v0[2], v0[3]); w.z = cvt_pk_bf16(v1[0], v1[1]); w.w = cvt_pk_bf16(v1[2], v1[3]);
                            *(u32x4*)(rowp + bj * HALF) = w; } }
            }
            return;
        }
        bf16_t* base = buf0 + (grp == 0 ? 0L : (grp == 1 ? OFF1 : OFF2));
        const int col0 = (u.pn & 3) * BM + wc * 32 + 8 * fq;
#pragma unroll
        for (int ai = 0; ai < 2; ++ai)
#pragma unroll
            for (int m = 0; m < 4; ++m) { bf16_t* rowp = base + (size_t)(row0 + ai * HALF + m * 16) * 1024 + col0;
#pragma unroll
                for (int bj = 0; bj < 2; ++bj) { f32x4 v0 = acc[ai][bj][m][0], v1 = acc[ai][bj][m][1];
                    if (MODE == 2) {
#pragma unroll
                        for (int j = 0; j < 4; ++j) { v0[j] = sigmoidf_(v0[j]); v1[j] = sigmoidf_(v1[j]); }
                        if (grp == 0) { const u32x4 o = *(const u32x4*)(rowp + bj * HALF);
                            v0[0] *= bf_lo(o.x); v0[1] *= bf_hi(o.x); v0[2] *= bf_lo(o.y); v0[3] *= bf_hi(o.y);
                            v1[0] *= bf_lo(o.z); v1[1] *= bf_hi(o.z); v1[2] *= bf_lo(o.w); v1[3] *= bf_hi(o.w); }
                    }
                    u32x4 w; w.x = cvt_pk_bf16(v0[0], v0[1]); w.y = cvt_pk_bf16(v0[2], v0[3]); w.z = cvt_pk_bf16(v1[0], v1[1]); w.w = cvt_pk_bf16(v1[2], v1[3]);
                    *(u32x4*)(rowp + bj * HALF) = w; } }
    }
};
template <bool SECOND> struct EpiBranch {
    static constexpr bool PERM = true, AFTER_DRAIN = false;
    bf16_t* G; const bf16_t* T1;
    __device__ __forceinline__ void operator()(const f32x4 (&acc)[2][2][4][2], const Unit& u, int wr, int wc, int fr, int fq) const {
        const int row0 = u.pm * BM + wr * 64 + fr, col0 = u.pn * BM + wc * 32 + 8 * fq;
#pragma unroll
        for (int ai = 0; ai < 2; ++ai)
#pragma unroll
            for (int m = 0; m < 4; ++m) { const size_t off = (size_t)(row0 + ai * HALF + m * 16) * 1024 + col0;
#pragma unroll
                for (int bj = 0; bj < 2; ++bj) { const f32x4 a0 = acc[ai][bj][m][0], a1 = acc[ai][bj][m][1];
                    const u32x4 g = *(const u32x4*)(G + off + bj * HALF);
                    float r[8] = { bf_lo(g.x) * a0[0], bf_hi(g.x) * a0[1], bf_lo(g.y) * a0[2], bf_hi(g.y) * a0[3], bf_lo(g.z) * a1[0], bf_hi(g.z) * a1[1], bf_lo(g.w) * a1[2], bf_hi(g.w) * a1[3] };
                    if (SECOND) { const u32x4 t = *(const u32x4*)(T1 + off + bj * HALF);
                        r[0] += bf_lo(t.x); r[1] += bf_hi(t.x); r[2] += bf_lo(t.y); r[3] += bf_hi(t.y); r[4] += bf_lo(t.z); r[5] += bf_hi(t.z); r[6] += bf_lo(t.w); r[7] += bf_hi(t.w); }
                    u32x4 w; w.x = cvt_pk_bf16(r[0], r[1]); w.y = cvt_pk_bf16(r[2], r[3]); w.z = cvt_pk_bf16(r[4], r[5]); w.w = cvt_pk_bf16(r[6], r[7]);
                    *(u32x4*)(G + off + bj * HALF) = w; } }
    }
};

template <class Epi, class Sched, bool ALIGN_EPI = false, bool SP2 = false>
__device__ __forceinline__ void gemm_phase(PG8_LAS unsigned char* lds, const Gemm g, const Sched& S, const Epi& E) {
    const int tid = threadIdx.x, wid = __builtin_amdgcn_readfirstlane(tid >> 6), lane = tid & 63, wr = wid >> 2, wc = wid & 3, fr = lane & 15, fq = lane >> 4;
    const int K = g.K, nt = K / BK;
    unsigned voffA[2], voffB[2];
#pragma unroll
    for (int i = 0; i < 2; ++i) { int R, C; stage_rc(tid * 16 + i * 8192, R, C); const int Rb = Epi::PERM ? ((R & ~31) + perm32(R & 31)) : R;
        voffA[i] = (unsigned)(R * K + C) * 2u; voffB[i] = (unsigned)(Rb * K + C) * 2u; }
    const size_t kstep = (size_t)(BK * 2);
    const size_t hstep = (size_t)HALF * K * 2;
    const size_t tstep = 2 * hstep;
    const unsigned ldsw = (unsigned)wid * 1024u;
    const int aoff = lds_byte(wr * 64 + fr, fq * 8), boff = lds_byte(wc * 32 + fr, fq * 8);
#define PG8_SA(b, h) (((b) * 2 + (h)) * HTB)
#define PG8_SB(b, h) ((4 + (b) * 2 + (h)) * HTB)
#define PG8_STAGE(bufoff, gbase, voff) do { _Pragma("unroll") for (int _i = 0; _i < 2; ++_i) \
        __builtin_amdgcn_global_load_lds((const unsigned*)((const char*)(gbase) + (voff)[_i]), (PG8_LAS unsigned*)(lds + (bufoff) + ldsw + _i * 8192), 16, 0, 0); } while (0)
#define PG8_LDA(dst, b, h) do { _Pragma("unroll") for (int m = 0; m < 4; ++m) _Pragma("unroll") for (int k = 0; k < 2; ++k) dst[m][k] = *(const PG8_LAS bf16x8*)(lds + PG8_SA(b, h) + aoff + m * 2048 + k * 1024); } while (0)
#define PG8_LDB(dst, b, h) do { _Pragma("unroll") for (int n = 0; n < 2; ++n) _Pragma("unroll") for (int k = 0; k < 2; ++k) dst[n][k] = *(const PG8_LAS bf16x8*)(lds + PG8_SB(b, h) + boff + n * 2048 + k * 1024); } while (0)
#define PG8_MMA(ai, bj, At, Bt) do { __builtin_amdgcn_s_setprio(1); _Pragma("unroll") for (int m = 0; m < 4; ++m) _Pragma("unroll") for (int n = 0; n < 2; ++n) _Pragma("unroll") for (int k = 0; k < 2; ++k) \
        acc[ai][bj][m][n] = __builtin_amdgcn_mfma_f32_16x16x32_bf16(Bt[n][k], At[m][k], acc[ai][bj][m][n], 0, 0, 0); __builtin_amdgcn_s_setprio(0); } while (0)
#define PG8_WAIT_V(n) asm volatile("s_waitcnt vmcnt(" #n ")" ::: "memory")
#define PG8_WAIT_L(n) asm volatile("s_waitcnt lgkmcnt(" #n ")" ::: "memory")
#define PG8_BAR __builtin_amdgcn_s_barrier()
#define PG8_SCHED __builtin_amdgcn_sched_barrier(0)
    Unit cur, nxt; int ui = 0;
    if (!S.next(0, cur)) return;
    f32x4 acc[2][2][4][2];
#pragma unroll
    for (int a = 0; a < 2; ++a)
#pragma unroll
        for (int b = 0; b < 2; ++b)
#pragma unroll
            for (int m = 0; m < 4; ++m)
#pragma unroll
                for (int n = 0; n < 2; ++n) acc[a][b][m][n] = (f32x4){0.f, 0.f, 0.f, 0.f};
    bf16x8 At[4][2], B0[2][2], B1[2][2];
    const char* cA = (const char*)g.A + (size_t)cur.pm * tstep; const char* cB = (const char*)g.Bt + (size_t)cur.pn * tstep;
    S.a_ready(cur);
    if constexpr (SP2) {
        PG8_STAGE(PG8_SB(0, 0), cB, voffB); PG8_STAGE(PG8_SB(0, 1), cB + hstep, voffB); PG8_STAGE(PG8_SA(0, 0), cA, voffA); PG8_STAGE(PG8_SA(0, 1), cA + hstep, voffA);
        if (wr == 1) PG8_BAR;
        PG8_WAIT_V(2); PG8_BAR;
        PG8_STAGE(PG8_SB(1, 0), cB + kstep, voffB); PG8_STAGE(PG8_SA(1, 0), cA + kstep, voffA); PG8_STAGE(PG8_SB(1, 1), cB + hstep + kstep, voffB);
        PG8_WAIT_V(6); PG8_BAR;
    } else {
        PG8_STAGE(PG8_SB(0, 0), cB, voffB); PG8_STAGE(PG8_SA(0, 0), cA, voffA); PG8_STAGE(PG8_SB(0, 1), cB + hstep, voffB); PG8_STAGE(PG8_SA(0, 1), cA + hstep, voffA);
        if (wr == 1) PG8_BAR;
        PG8_WAIT_V(4); PG8_BAR;
        PG8_STAGE(PG8_SB(1, 0), cB + kstep, voffB); PG8_STAGE(PG8_SA(1, 0), cA + kstep, voffA); PG8_STAGE(PG8_SB(1, 1), cB + hstep + kstep, voffB);
        PG8_WAIT_V(6); PG8_BAR;
    }
    for (;;) {
        const bool has_next = S.next(ui + 1, nxt);
        const char* nA = has_next ? (const char*)g.A + (size_t)nxt.pm * tstep : cA; const char* nB = has_next ? (const char*)g.Bt + (size_t)nxt.pn * tstep : cB;
        for (int t = 0; t < nt; t += 2) {
            const bool last = (t == nt - 2);
            const char* a1 = cA + (size_t)(t + 1) * kstep;
            const char* a2 = last ? nA : cA + (size_t)(t + 2) * kstep; const char* b2 = last ? nB : cB + (size_t)(t + 2) * kstep;
            const char* a3 = a2 + kstep; const char* b3 = b2 + kstep;
            if (last && has_next) S.a_ready(nxt);
            if constexpr (SP2) {
            PG8_LDB(B0, 0, 0); PG8_LDB(B1, 0, 1); PG8_SCHED; PG8_LDA(At, 0, 0); PG8_STAGE(PG8_SA(1, 1), a1 + hstep, voffA);
            PG8_WAIT_V(8); PG8_WAIT_L(0); PG8_BAR; PG8_MMA(0, 0, At, B0); PG8_MMA(0, 1, At, B1); PG8_BAR; PG8_SCHED;
            PG8_LDA(At, 0, 1); PG8_STAGE(PG8_SB(0, 0), b2, voffB); PG8_STAGE(PG8_SB(0, 1), b2 + hstep, voffB); PG8_STAGE(PG8_SA(0, 0), a2, voffA);
            PG8_WAIT_V(8); PG8_WAIT_L(0); PG8_BAR; PG8_MMA(1, 0, At, B0); PG8_MMA(1, 1, At, B1); PG8_BAR; PG8_SCHED;
            PG8_LDB(B0, 1, 0); PG8_LDB(B1, 1, 1); PG8_SCHED; PG8_LDA(At, 1, 0); PG8_STAGE(PG8_SA(0, 1), a2 + hstep, voffA);
            PG8_WAIT_V(8); PG8_WAIT_L(0); PG8_BAR; PG8_MMA(0, 0, At, B0); PG8_MMA(0, 1, At, B1); PG8_BAR; PG8_SCHED;
            PG8_LDA(At, 1, 1); PG8_STAGE(PG8_SB(1, 0), b3, voffB); PG8_STAGE(PG8_SB(1, 1), b3 + hstep, voffB); PG8_STAGE(PG8_SA(1, 0), a3, voffA);
            PG8_WAIT_V(8); PG8_WAIT_L(0); PG8_BAR; PG8_MMA(1, 0, At, B0); PG8_MMA(1, 1, At, B1); PG8_BAR; PG8_SCHED;
            } else {
            PG8_LDB(B0, 0, 0); PG8_SCHED; PG8_LDA(At, 0, 0); PG8_STAGE(PG8_SA(1, 1), a1 + hstep, voffA);
            PG8_WAIT_L(8); PG8_BAR; PG8_WAIT_L(0); PG8_MMA(0, 0, At, B0); PG8_BAR; PG8_SCHED;
            PG8_LDB(B1, 0, 1); PG8_STAGE(PG8_SB(0, 0), b2, voffB);
            PG8_BAR; PG8_WAIT_L(0); PG8_MMA(0, 1, At, B1); PG8_BAR;
            PG8_LDA(At, 0, 1); PG8_STAGE(PG8_SA(0, 0), a2, voffA);
            PG8_BAR; PG8_WAIT_L(0); PG8_MMA(1, 0, At, B0); PG8_BAR; PG8_SCHED;
            PG8_STAGE(PG8_SB(0, 1), b2 + hstep, voffB);
            PG8_WAIT_V(6); PG8_BAR; PG8_MMA(1, 1, At, B1); PG8_BAR;
            PG8_LDB(B0, 1, 0); PG8_SCHED; PG8_LDA(At, 1, 0); PG8_STAGE(PG8_SA(0, 1), a2 + hstep, voffA);
            PG8_WAIT_L(8); PG8_BAR; PG8_WAIT_L(0); PG8_MMA(0, 0, At, B0); PG8_BAR; PG8_SCHED;
            PG8_LDB(B1, 1, 1); PG8_STAGE(PG8_SB(1, 0), b3, voffB);
            PG8_BAR; PG8_WAIT_L(0); PG8_MMA(0, 1, At, B1); PG8_BAR;
            PG8_LDA(At, 1, 1); PG8_STAGE(PG8_SA(1, 0), a3, voffA);
            PG8_BAR; PG8_WAIT_L(0); PG8_MMA(1, 0, At, B0); PG8_BAR; PG8_SCHED;
            PG8_STAGE(PG8_SB(1, 1), b3 + hstep, voffB);
            PG8_WAIT_V(6); PG8_BAR; PG8_MMA(1, 1, At, B1); PG8_BAR;
            }
        }
        if constexpr (ALIGN_EPI) { if (wr == 0) PG8_BAR; }
        if constexpr (!Epi::AFTER_DRAIN) { E(acc, cur, wr, wc, fr, fq); S.done(cur); }
        if (!has_next) break;
#pragma unroll
        for (int a = 0; a < 2; ++a)
#pragma unroll
            for (int b = 0; b < 2; ++b)
#pragma unroll
                for (int m = 0; m < 4; ++m)
#pragma unroll
                    for (int n = 0; n < 2; ++n) acc[a][b][m][n] = (f32x4){0.f, 0.f, 0.f, 0.f};
        cur = nxt; cA = nA; cB = nB; ++ui;
        if constexpr (ALIGN_EPI) { if (wr == 1) PG8_BAR; }
    }
    PG8_WAIT_V(0);
    if constexpr (!ALIGN_EPI) { if (wr == 0) PG8_BAR; }
    PG8_BAR;
    if constexpr (Epi::AFTER_DRAIN) { E.fused(acc, cur, wr, wc, fr, fq, lds, wid, lane); S.done(cur); }
#undef PG8_SA
#undef PG8_SB
#undef PG8_STAGE
#undef PG8_LDA
#undef PG8_LDB
#undef PG8_MMA
#undef PG8_WAIT_V
#undef PG8_WAIT_L
#undef PG8_BAR
#undef PG8_SCHED
}
}

constexpr int NWAVES = 8, NTHR = 512;
constexpr int BATCH = 2, T = 8192, D = 1024, FF = 2816, M = BATCH * T;
constexpr int WIN_LD = 9480;
constexpr float ALPHA = 1.189207115002721f;
constexpr size_t MiB = 1u << 20;
constexpr size_t WS_GATES = 1 * MiB;
constexpr size_t WS_CT = WS_GATES + 512 * 1024;
constexpr size_t WS_NLOC = WS_CT + 1 * MiB;
constexpr size_t WS_GC = WS_NLOC + 512 * 1024;
constexpr size_t WS_W2T = WS_GC + 64 * 1024;
constexpr size_t WS_A2T = WS_W2T + 128 * 1024;
constexpr size_t WS_G2T = WS_A2T + 128 * 1024;
constexpr size_t WS_WIN1 = 4 * MiB;
constexpr size_t WS_WIN2 = WS_WIN1 + 6656 * 1024;
constexpr size_t WS_WIN3 = WS_WIN2 + 6656 * 1024;
constexpr size_t WS_WA = 23 * MiB, WS_WB = 25 * MiB, WS_WO = 27 * MiB;
constexpr size_t WS_WF = 29 * MiB;
constexpr size_t WS_WFD = 40 * MiB;
constexpr size_t WS_XB = 46 * MiB;
constexpr size_t WS_B = 78 * MiB, WS_C = 110 * MiB, WS_D = 142 * MiB, WS_E = 174 * MiB;
constexpr size_t WS_H = WS_B;
constexpr size_t WS_RV = WS_E, WS_LR = WS_E + 32 * MiB, WS_YR = WS_E + 40 * MiB;
constexpr size_t WS_END = WS_YR + 32 * MiB;
static_assert(WS_G2T + 256 * 1024 <= WS_WIN1 && WS_WIN3 + 6 * MiB <= WS_WA && WS_WFD + 5632 * 1024 <= WS_XB && WS_H + (size_t)M * FF * 2 <= WS_E && WS_END <= 256 * MiB, "ws map");
constexpr int LDS_BYTES = 147456;

#define LAS __attribute__((address_space(3)))
typedef unsigned short bf16;
typedef unsigned v4u __attribute__((ext_vector_type(4)));
typedef float f32x4 __attribute__((ext_vector_type(4)));
typedef float f32x16 __attribute__((ext_vector_type(16)));
typedef short bf16x8 __attribute__((ext_vector_type(8)));
__device__ __forceinline__ unsigned f2bf(float f) { unsigned u = __builtin_bit_cast(unsigned, f); return (u + 0x7fffu + ((u >> 16) & 1u)) >> 16; }
__device__ __forceinline__ unsigned pk2(float lo, float hi) { return pg8::cvt_pk_bf16(lo, hi); }
__device__ __forceinline__ float bfl(unsigned w) { return __uint_as_float(w << 16); }
__device__ __forceinline__ float bfh(unsigned w) { return __uint_as_float(w & 0xffff0000u); }
__device__ __forceinline__ float bf1(bf16 h) { return __uint_as_float((unsigned)h << 16); }
__device__ __forceinline__ void unpack8(const v4u w, float (&o)[8]) { o[0] = bfl(w.x); o[1] = bfh(w.x); o[2] = bfl(w.y); o[3] = bfh(w.y); o[4] = bfl(w.z); o[5] = bfh(w.z); o[6] = bfl(w.w); o[7] = bfh(w.w); }
__device__ __forceinline__ float sigm(float x) { return 1.0f / (1.0f + __expf(-x)); }
__device__ __forceinline__ float wave_sum(float v) {
#pragma unroll
    for (int o = 1; o < 64; o <<= 1) v += __shfl_xor(v, o);
    return v;
}
#define MFMA32(a, b, c) __builtin_amdgcn_mfma_f32_32x32x16_bf16(a, b, c, 0, 0, 0)

struct Ptrs {
    const float* x; const float *f1g, *f1u, *f1d, *ln1g, *ln1b, *win, *cw, *cb, *ib, *fb, *mng, *rmu, *rw0, *rw2, *ra0, *ra2, *rg2, *rkk, *rka, *rrk, *gng, *gnb, *wa, *wb, *wo, *ln2g, *ln2b, *f2g, *f2u, *f2d, *ln3g, *ln3b;
    float* out; unsigned char* ws;
};

__device__ __forceinline__ void tr_item(const float* W, int ldw, int K, int src_col0, int nvalid, bf16* WT, int dst_row0, int k0, LAS float* scr, int lane) {
    const int n_ = lane & 31;
#pragma unroll 8
    for (int i = 0; i < 32; ++i) { const int kk = 2 * i + (lane >> 5); scr[kk * 33 + n_] = (n_ < nvalid) ? W[(size_t)(k0 + kk) * ldw + src_col0 + n_] : 0.f; }
    asm volatile("s_waitcnt lgkmcnt(0)" ::: "memory");
    const int c = lane & 7;
#pragma unroll
    for (int j = 0; j < 4; ++j) { const int n = (lane >> 3) + 8 * j; const LAS float* s = scr + (8 * c) * 33 + n;
        v4u o; o.x = pk2(s[0 * 33], s[1 * 33]); o.y = pk2(s[2 * 33], s[3 * 33]); o.z = pk2(s[4 * 33], s[5 * 33]); o.w = pk2(s[6 * 33], s[7 * 33]);
        *(v4u*)(WT + (size_t)(dst_row0 + n) * K + k0 + 8 * c) = o; }
    asm volatile("s_waitcnt lgkmcnt(0)" ::: "memory");
}
template <int KIND> __device__ __forceinline__ void conv_mat(const float* W, const float* W2, int ldw, int K, bf16* WT, int nrows, LAS float* scr, int gw, int NGW, int lane) {
    const int nkb = K / 64, items = (nrows / 32) * nkb;
    for (int it = gw; it < items; it += NGW) {
        const int nb = it / nkb, kb = it % nkb, r0 = nb * 32; const float* src = W; int sc = r0, nv = 32;
        if (KIND == 1) { const int g = r0 >> 8, wi = r0 & 255; src = wi < 128 ? W : W2; sc = g * 128 + (wi & 127); }
        if (KIND == 2) { if (r0 < 3072) sc = r0; else if (r0 == 3072) { sc = 4096; nv = 8; } else { sc = 0; nv = 0; } }
        if (KIND == 3) sc = 4104 + r0;
        if (KIND == 4) sc = r0 < 1024 ? 3072 + r0 : 7432 + (r0 - 1024);
        tr_item(src, ldw, K, sc, nv, WT, r0, kb * 64, scr, lane);
    }
}
__device__ __forceinline__ void cvt_rows_bf16(const float* X, bf16* O, int gw, int NGW, int lane) {
    for (int m = gw; m < M; m += NGW) { const f32x4* xr = (const f32x4*)(X + (size_t)m * D) + lane; unsigned long long* o8 = (unsigned long long*)(O + (size_t)m * D) + lane;
#pragma unroll
        for (int j = 0; j < 4; ++j) { const f32x4 v = xr[64 * j]; o8[64 * j] = (unsigned long long)pk2(v.x, v.y) | ((unsigned long long)pk2(v.z, v.w) << 32); } }
}
__device__ __forceinline__ void ln_rows(const float* Y, const float* g, const float* b, float* outf, bf16* outb, int gw, int NGW, int lane) {
    f32x4 gv[4], bv[4];
#pragma unroll
    for (int j = 0; j < 4; ++j) { gv[j] = ((const f32x4*)g)[lane + 64 * j]; bv[j] = ((const f32x4*)b)[lane + 64 * j]; }
    for (int m = gw; m < M; m += NGW) {
        const f32x4* xr = (const f32x4*)(Y + (size_t)m * D) + lane;
        f32x4 v[4]; float s = 0.f;
#pragma unroll
        for (int j = 0; j < 4; ++j) { v[j] = xr[64 * j]; s += (v[j].x + v[j].y) + (v[j].z + v[j].w); }
        const float mean = wave_sum(s) * (1.f / D); float s2 = 0.f;
#pragma unroll
        for (int j = 0; j < 4; ++j) { v[j] = v[j] - mean; s2 += (v[j].x * v[j].x + v[j].y * v[j].y) + (v[j].z * v[j].z + v[j].w * v[j].w); }
        const float rstd = 1.f / sqrtf(wave_sum(s2) * (1.f / D) + 1e-5f);
        f32x4* of = (f32x4*)(outf + (size_t)m * D) + lane;
#pragma unroll
        for (int j = 0; j < 4; ++j) { v[j] = v[j] * rstd * gv[j] + bv[j]; of[64 * j] = v[j]; }
        if (outb) { unsigned long long* o8 = (unsigned long long*)(outb + (size_t)m * D) + lane;
#pragma unroll
            for (int j = 0; j < 4; ++j) o8[64 * j] = (unsigned long long)pk2(v[j].x, v[j].y) | ((unsigned long long)pk2(v[j].z, v[j].w) << 32); }
    }
}

__device__ __forceinline__ void conv8(const bf16* X, int row, int t, int col0, const float* cw, const float* cb, int cc0, float scale, float (&o)[8]) {
    float a[8];
#pragma unroll
    for (int j = 0; j < 8; ++j) a[j] = cb[cc0 + j];
#pragma unroll
    for (int tap = 0; tap < 4; ++tap) {
        const int dt = 3 - tap;
        if (t - dt >= 0) { float xv[8]; unpack8(*(const v4u*)(X + (size_t)(row - dt) * 1024 + col0), xv);
#pragma unroll
            for (int j = 0; j < 8; ++j) a[j] += xv[j] * cw[tap * 2048 + cc0 + j]; }
    }
#pragma unroll
    for (int j = 0; j < 8; ++j) o[j] = a[j] / (1.0f + __expf(-a[j])) * scale;
}
__device__ __forceinline__ void chunk_gates(const float* gates, int row0, int h, LAS float* tmp, LAS float* fbv, LAS float* iv, int tid) {
    if (tid < 128) { tmp[tid] = gates[(size_t)(row0 + tid) * 8 + 4 + h]; iv[tid] = gates[(size_t)(row0 + tid) * 8 + h]; }
    __syncthreads();
    if (tid < 128) { float s = 0.f; for (int j = 0; j <= tid; ++j) s += tmp[j]; fbv[tid] = s; }
    __syncthreads();
}
__device__ __forceinline__ void mlstm_passA(const Ptrs& P, LAS unsigned char* lds, int unit, int tid, int wave, int lane) {
    const bf16* MK = (const bf16*)(P.ws + WS_C); const bf16* MV = (const bf16*)(P.ws + WS_D); const float* gates = (const float*)(P.ws + WS_GATES);
    bf16* CB = (bf16*)(P.ws + WS_E) + (size_t)unit * 65536; float* NL = (float*)(P.ws + WS_NLOC) + unit * 256; float* GC = (float*)(P.ws + WS_GC);
    const int c = unit & 63, h = (unit >> 6) & 3, b = unit >> 8, row0 = b * T + c * 128;
    LAS bf16* VT = (LAS bf16*)lds; LAS bf16* KT = (LAS bf16*)(lds + 69632);
    LAS float* fbv = (LAS float*)(lds + 139264); LAS float* wa = fbv + 128; LAS float* tmp = wa + 128; LAS float* iv = tmp + 128;
    chunk_gates(gates, row0, h, tmp, fbv, iv, tid);
    const float G = fbv[127];
    if (tid < 128) wa[tid] = __expf(G - fbv[tid] + iv[tid]);
    __syncthreads();
    { const int s = tid & 127, g = tid >> 7; const float w_s = wa[s]; const int row = row0 + s, t = c * 128 + s;
#pragma unroll 2
      for (int i = 0; i < 8; ++i) { const int d0 = g * 64 + i * 8; float xv[8]; unpack8(*(const v4u*)(MV + (size_t)row * 1024 + h * 256 + d0), xv);
#pragma unroll
          for (int j = 0; j < 8; ++j) VT[(d0 + j) * 136 + s] = (bf16)f2bf(xv[j] * w_s);
          float kv[8]; conv8(MK, row, t, h * 256 + d0, P.cw, P.cb, 1024 + h * 256 + d0, 1.0f, kv);
#pragma unroll
          for (int j = 0; j < 8; ++j) KT[(d0 + j) * 136 + s] = (bf16)f2bf(kv[j]); } }
    __syncthreads();
    const int lr_ = lane & 31, lh = lane >> 5;
    if (tid < 256) { float s = 0.f; for (int j = 0; j < 128; ++j) s += bf1(KT[tid * 136 + j]) * wa[j]; NL[tid] = s; }
    if (tid == 0) GC[unit] = G;
    for (int hf = 0; hf < 2; ++hf) {
        f32x16 acc[4];
#pragma unroll
        for (int i = 0; i < 4; ++i)
#pragma unroll
            for (int j = 0; j < 16; ++j) acc[i][j] = 0.f;
#pragma unroll 2
        for (int ks = 0; ks < 8; ++ks) {
            const bf16x8 a = *(const LAS bf16x8*)(VT + (wave * 32 + lr_) * 136 + ks * 16 + 8 * lh);
#pragma unroll
            for (int nt = 0; nt < 4; ++nt) { const bf16x8 bb = *(const LAS bf16x8*)(KT + ((hf * 4 + nt) * 32 + lr_) * 136 + ks * 16 + 8 * lh); acc[nt] = MFMA32(a, bb, acc[nt]); }
        }
        bf16* cb0 = CB + (wave * 32 + 4 * lh) * 256 + hf * 128 + lr_;
#pragma unroll
        for (int nt = 0; nt < 4; ++nt)
#pragma unroll
            for (int r = 0; r < 16; ++r) cb0[((r & 3) + 8 * (r >> 2)) * 256 + nt * 32] = (bf16)f2bf(acc[nt][r]);
    }
    __syncthreads();
}
__device__ __forceinline__ void mlstm_passB(const Ptrs& P, int gtid, int gthreads) {
    bf16* CB = (bf16*)(P.ws + WS_E); float* NL = (float*)(P.ws + WS_NLOC); const float* GC = (const float*)(P.ws + WS_GC);
    for (int i = gtid; i < 8 * 16384; i += gthreads) {
        const int bh = i >> 14, e4 = i & 16383; float st[4] = {0.f, 0.f, 0.f, 0.f};
#pragma unroll 4
        for (int c = 0; c < 64; ++c) { unsigned long long* p = (unsigned long long*)(CB + ((size_t)(bh * 64 + c) * 65536 + e4 * 4)); const unsigned long long w = *p;
            const float dec = __expf(GC[bh * 64 + c]); const unsigned lo = (unsigned)w, hi = (unsigned)(w >> 32);
            *p = (unsigned long long)pk2(st[0], st[1]) | ((unsigned long long)pk2(st[2], st[3]) << 32);
            st[0] = st[0] * dec + bfl(lo); st[1] = st[1] * dec + bfh(lo); st[2] = st[2] * dec + bfl(hi); st[3] = st[3] * dec + bfh(hi); }
    }
    for (int i = gtid; i < 8 * 256; i += gthreads) { const int bh = i >> 8, d = i & 255; float st = 0.f;
        for (int c = 0; c < 64; ++c) { float* p = NL + (bh * 64 + c) * 256 + d; const float v = *p; *p = st; st = st * __expf(GC[bh * 64 + c]) + v; } }
}
__device__ __forceinline__ void mlstm_passC(const Ptrs& P, LAS unsigned char* lds, int unit, int tid, int wave, int lane) {
    asm volatile("" : "+v"(tid), "+v"(lane));
    const bf16* MQ = (const bf16*)(P.ws + WS_B); const bf16* MK = (const bf16*)(P.ws + WS_C); bf16* MV = (bf16*)(P.ws + WS_D); const float* gates = (const float*)(P.ws + WS_GATES);
    const bf16* CT = (const bf16*)(P.ws + WS_E) + (size_t)unit * 65536; const float* NP = (const float*)(P.ws + WS_NLOC) + unit * 256;
    const int c = unit & 63, h = (unit >> 6) & 3, b = unit >> 8, row0 = b * T + c * 128;
    LAS bf16* Q = (LAS bf16*)lds; LAS bf16* K = (LAS bf16*)(lds + 67584); LAS bf16* SS = K; LAS bf16* VT = (LAS bf16*)(lds + 67584 + 34816);
    LAS float* fbv = (LAS float*)(lds + 137216); LAS float* es = fbv + 128; LAS float* tmp = es + 128; LAS float* iv = tmp + 128; LAS float* npv = iv + 128; LAS float* den = npv + 256;
    LAS float* Hs = (LAS float*)lds;
    chunk_gates(gates, row0, h, tmp, fbv, iv, tid);
    if (tid < 128) es[tid] = __expf(iv[tid] - fbv[tid]);
    if (tid < 256) npv[tid] = NP[tid];
    { const int s = tid & 127, g = tid >> 7; const int row = row0 + s, t = c * 128 + s;
#pragma unroll 2
      for (int i = 0; i < 8; ++i) { const int d0 = g * 64 + i * 8; float qv[8], kv[8];
          conv8(MQ, row, t, h * 256 + d0, P.cw, P.cb, h * 256 + d0, 0.0625f, qv); conv8(MK, row, t, h * 256 + d0, P.cw, P.cb, 1024 + h * 256 + d0, 1.0f, kv);
          v4u wq, wk; wq.x = pk2(qv[0], qv[1]); wq.y = pk2(qv[2], qv[3]); wq.z = pk2(qv[4], qv[5]); wq.w = pk2(qv[6], qv[7]);
          wk.x = pk2(kv[0], kv[1]); wk.y = pk2(kv[2], kv[3]); wk.z = pk2(kv[4], kv[5]); wk.w = pk2(kv[6], kv[7]);
          *(LAS v4u*)(Q + s * 264 + d0) = wq; *(LAS v4u*)(K + s * 264 + d0) = wk; } }
    __syncthreads();
    const int lr_ = lane & 31, lh = lane >> 5, rt = wave >> 1, wp = wave & 1;
    {
        f32x16 sacc[2];
#pragma unroll
        for (int i = 0; i < 2; ++i)
#pragma unroll
            for (int j = 0; j < 16; ++j) sacc[i][j] = 0.f;
#pragma unroll 4
        for (int ks = 0; ks < 16; ++ks) {
            const bf16x8 a = *(const LAS bf16x8*)(Q + (rt * 32 + lr_) * 264 + ks * 16 + 8 * lh);
#pragma unroll
            for (int j = 0; j < 2; ++j) { const bf16x8 bb = *(const LAS bf16x8*)(K + ((wp * 2 + j) * 32 + lr_) * 264 + ks * 16 + 8 * lh); sacc[j] = MFMA32(a, bb, sacc[j]); }
        }
        __syncthreads();
#pragma unroll
        for (int j = 0; j < 2; ++j) { const int s = (wp * 2 + j) * 32 + lr_; const float e = es[s];
#pragma unroll
            for (int r = 0; r < 16; ++r) { const int t = rt * 32 + (r & 3) + 8 * (r >> 2) + 4 * lh; SS[t * 136 + s] = (bf16)f2bf(s <= t ? sacc[j][r] * e : 0.f); } }
    }
    f32x16 acc[2][2];
#pragma unroll
    for (int i = 0; i < 2; ++i)
#pragma unroll
        for (int j = 0; j < 2; ++j)
#pragma unroll
            for (int r = 0; r < 16; ++r) acc[i][j][r] = 0.f;
#pragma unroll 2
    for (int ks = 0; ks < 16; ++ks) {
        const bf16x8 a = *(const LAS bf16x8*)(Q + (rt * 32 + lr_) * 264 + ks * 16 + 8 * lh);
#pragma unroll
        for (int hv = 0; hv < 2; ++hv)
#pragma unroll
            for (int j = 0; j < 2; ++j) { const int v = hv * 128 + (wp * 2 + j) * 32 + lr_; const bf16x8 bb = *(const bf16x8*)(CT + (size_t)v * 256 + ks * 16 + 8 * lh); acc[hv][j] = MFMA32(a, bb, acc[hv][j]); }
    }
    for (int hv = 0; hv < 2; ++hv) {
        { const int s = tid & 127, g = tid >> 7; const int row = row0 + s;
#pragma unroll
          for (int i = 0; i < 4; ++i) { const int d0 = g * 32 + i * 8; float xv[8]; unpack8(*(const v4u*)(MV + (size_t)row * 1024 + h * 256 + hv * 128 + d0), xv);
#pragma unroll
              for (int j = 0; j < 8; ++j) VT[(d0 + j) * 136 + s] = (bf16)f2bf(xv[j]); } }
        __syncthreads();
        if (hv == 0 && tid < 128) { float s1 = 0.f; for (int j = 0; j < 128; ++j) s1 += bf1(SS[tid * 136 + j]); float s2 = 0.f; for (int j = 0; j < 256; ++j) s2 += bf1(Q[tid * 264 + j]) * npv[j]; den[tid] = s1 + s2; }
#pragma unroll 2
        for (int ks = 0; ks < 8; ++ks) {
            const bf16x8 a = *(const LAS bf16x8*)(SS + (rt * 32 + lr_) * 136 + ks * 16 + 8 * lh);
#pragma unroll
            for (int j = 0; j < 2; ++j) { const bf16x8 bb = *(const LAS bf16x8*)(VT + ((wp * 2 + j) * 32 + lr_) * 136 + ks * 16 + 8 * lh);
                if (hv == 0) acc[0][j] = MFMA32(a, bb, acc[0][j]); else acc[1][j] = MFMA32(a, bb, acc[1][j]); }
        }
        __syncthreads();
    }
    { LAS float* hs0 = Hs + (rt * 32 + 4 * lh) * 260 + wp * 64 + lr_;
#pragma unroll
      for (int r = 0; r < 16; ++r) { const int t = rt * 32 + (r & 3) + 8 * (r >> 2) + 4 * lh; const float eb = __expf(fbv[t]); const float sc = eb / fmaxf(fabsf(eb * den[t]), 1.0f);
#pragma unroll
          for (int hv = 0; hv < 2; ++hv)
#pragma unroll
              for (int j = 0; j < 2; ++j) hs0[((r & 3) + 8 * (r >> 2)) * 260 + hv * 128 + j * 32] = acc[hv][j][r] * sc; } }
    __syncthreads();
    for (int i = 0; i < 16; ++i) { const int t = wave * 16 + i; float x[4]; float s = 0.f;
#pragma unroll
        for (int j = 0; j < 4; ++j) { x[j] = Hs[t * 260 + lane + 64 * j]; s += x[j]; }
        const float mean = wave_sum(s) * (1.f / 256.f); float s2 = 0.f;
#pragma unroll
        for (int j = 0; j < 4; ++j) { x[j] -= mean; s2 += x[j] * x[j]; }
        const float rstd = 1.f / sqrtf(wave_sum(s2) * (1.f / 256.f) + 1e-5f);
#pragma unroll
        for (int j = 0; j < 4; ++j) { const int v = lane + 64 * j; MV[(size_t)(row0 + t) * 1024 + h * 256 + v] = (bf16)f2bf(x[j] * rstd * P.mng[h * 256 + v]); } }
    __syncthreads();
}

__device__ __forceinline__ float dpp_xor1(float x) { return __builtin_bit_cast(float, __builtin_amdgcn_update_dpp(0, __builtin_bit_cast(int, x), 0xB1, 0xF, 0xF, true)); }
__device__ __forceinline__ float dpp_xor2(float x) { return __builtin_bit_cast(float, __builtin_amdgcn_update_dpp(0, __builtin_bit_cast(int, x), 0x4E, 0xF, 0xF, true)); }
__device__ __forceinline__ float dpp_hmir(float x) { return __builtin_bit_cast(float, __builtin_amdgcn_update_dpp(0, __builtin_bit_cast(int, x), 0x141, 0xF, 0xF, true)); }
__device__ __forceinline__ float red8(float x) { x += dpp_xor1(x); x += dpp_xor2(x); x += dpp_hmir(x); return x; }
__device__ __forceinline__ void shift8(const bf16* X, int ld, int row, int t, int col0, const float* mu, float (&o)[8]) {
    float xc[8]; unpack8(*(const v4u*)(X + (size_t)row * ld + col0), xc);
    float xp[8];
    if (t > 0) unpack8(*(const v4u*)(X + (size_t)(row - 1) * ld + col0), xp); else {
#pragma unroll
        for (int j = 0; j < 8; ++j) xp[j] = 0.f; }
#pragma unroll
    for (int j = 0; j < 8; ++j) o[j] = xc[j] + (xp[j] - xc[j]) * mu[j];
}
__device__ __forceinline__ float dpp_rmir(float x) { return __builtin_bit_cast(float, __builtin_amdgcn_update_dpp(0, __builtin_bit_cast(int, x), 0x140, 0xF, 0xF, true)); }
__device__ __forceinline__ float red16(float x) { x += dpp_xor1(x); x += dpp_xor2(x); x += dpp_hmir(x); x += dpp_rmir(x); return x; }
struct RawRows { v4u rc, rp, kc, kp, wc, wp, ac, ap, vc, vp; };
__device__ __forceinline__ void rw_load(RawRows& R, const bf16* RR, const bf16* RK, const bf16* RV, const bf16* LR, int row, int t, int hc, int c0, int vcol, bool dov) {
    const v4u z = {0u, 0u, 0u, 0u};
    R.rc = *(const v4u*)(RR + (size_t)row * 1024 + hc); R.kc = *(const v4u*)(RK + (size_t)row * 1024 + hc);
    R.wc = *(const v4u*)(LR + (size_t)row * 256 + c0); R.ac = *(const v4u*)(LR + (size_t)row * 256 + 64 + c0);
    if (t > 0) { R.rp = *(const v4u*)(RR + (size_t)(row - 1) * 1024 + hc); R.kp = *(const v4u*)(RK + (size_t)(row - 1) * 1024 + hc);
        R.wp = *(const v4u*)(LR + (size_t)(row - 1) * 256 + c0); R.ap = *(const v4u*)(LR + (size_t)(row - 1) * 256 + 64 + c0); }
    else { R.rp = z; R.kp = z; R.wp = z; R.ap = z; }
    if (dov) { R.vc = *(const v4u*)(RV + (size_t)row * 1024 + vcol); R.vp = t > 0 ? *(const v4u*)(RV + (size_t)(row - 1) * 1024 + vcol) : z; } else { R.vc = z; R.vp = z; }
}
__device__ __forceinline__ void lerp8(const v4u c, const v4u p, const float (&mu)[8], float (&o)[8]) {
    float xc[8], xp[8]; unpack8(c, xc); unpack8(p, xp);
#pragma unroll
    for (int j = 0; j < 8; ++j) o[j] = xc[j] + (xp[j] - xc[j]) * mu[j];
}
__device__ __forceinline__ void rwkv_unit(const Ptrs& P, LAS unsigned char* lds, int unit, int tid, int wave, int lane) {
    const bf16* RR = (const bf16*)(P.ws + WS_B); const bf16* RK = (const bf16*)(P.ws + WS_C); const bf16* RV = (const bf16*)(P.ws + WS_RV); const bf16* LR = (const bf16*)(P.ws + WS_LR);
    bf16* YR = (bf16*)(P.ws + WS_YR); float* CTB = (float*)(P.ws + WS_CT);
    const bf16* W2T = (const bf16*)(P.ws + WS_W2T); const bf16* A2T = (const bf16*)(P.ws + WS_A2T);
    const int rg = unit & 7, h = (unit >> 3) & 15, b = unit >> 7;
    LAS float* Wd = (LAS float*)lds;
    LAS float* Aa = Wd + 4096;
    LAS float* Bb = Aa + 4096;
    LAS float* Kp = Bb + 4096;
    LAS float* RW = Kp + 4096;
    LAS float* AL = RW + 4096;
    LAS bf16* TW = (LAS bf16*)(AL + 4096);
    LAS bf16* TA = TW + 64 * 72;
    LAS float* Vv = (LAS float*)(TA + 64 * 72);
    LAS float* SC = Vv + 512;
    LAS float* YB = SC + 128;
    const int tok = tid >> 3, part = tid & 7, c0 = part * 8, hc = h * 64 + c0, vcol = h * 64 + rg * 8;
    float kkc[8], kac[8], rrk[8], mur[8], muk[8], muw[8], mua[8], muv[8];
#pragma unroll
    for (int j = 0; j < 8; ++j) { kkc[j] = P.rkk[hc + j]; kac[j] = P.rka[hc + j]; rrk[j] = P.rrk[hc + j]; mur[j] = P.rmu[hc + j]; muk[j] = P.rmu[1024 + hc + j]; muw[j] = P.rmu[3072 + c0 + j]; mua[j] = P.rmu[3136 + c0 + j]; muv[j] = P.rmu[2048 + vcol + j]; }
    const int lr_ = lane & 31, lh = lane >> 5;
    const int mat = wave >> 2, mrt = (wave >> 1) & 1, mct = wave & 1, mcc = mct * 32 + lr_;
    bf16x8 bfr[4];
    { const bf16* Bg = (mat ? A2T : W2T) + (size_t)(h * 64 + mcc) * 64;
#pragma unroll
      for (int ks = 0; ks < 4; ++ks) bfr[ks] = *(const bf16x8*)(Bg + ks * 16 + 8 * lh); }
    const float mbias = mat ? P.ra0[h * 64 + mcc] : P.rw0[h * 64 + mcc];
    const int rl = lane >> 4, q4 = (lane & 15) * 4, ro = (wave & 1) * 4 + rl;
    f32x4 S = {0.f, 0.f, 0.f, 0.f};
    RawRows R; rw_load(R, RR, RK, RV, LR, b * T + tok, tok, hc, c0, vcol, part == 0);
    for (int ch = 0; ch < T / 64; ++ch) {
        const int t = ch * 64 + tok, row = b * T + t;
        float r8[8], k8[8];
        lerp8(R.rc, R.rp, mur, r8); lerp8(R.kc, R.kp, muk, k8);
        { float w8[8], a8[8]; lerp8(R.wc, R.wp, muw, w8); lerp8(R.ac, R.ap, mua, a8);
#pragma unroll
          for (int j = 0; j < 8; ++j) { const float e2 = __expf(2.f * w8[j]); w8[j] = 1.f - 2.f / (e2 + 1.f); }
          v4u pw, pa; pw.x = pk2(w8[0], w8[1]); pw.y = pk2(w8[2], w8[3]); pw.z = pk2(w8[4], w8[5]); pw.w = pk2(w8[6], w8[7]);
          pa.x = pk2(a8[0], a8[1]); pa.y = pk2(a8[2], a8[3]); pa.z = pk2(a8[4], a8[5]); pa.w = pk2(a8[6], a8[7]);
          *(LAS v4u*)(TW + tok * 72 + c0) = pw; *(LAS v4u*)(TA + tok * 72 + c0) = pa; }
        if (part == 0) { float v8[8]; lerp8(R.vc, R.vp, muv, v8);
#pragma unroll
            for (int j = 0; j < 8; ++j) Vv[tok * 8 + j] = v8[j]; }
        if (ch + 1 < T / 64) rw_load(R, RR, RK, RV, LR, row + 64, t + 64, hc, c0, vcol, part == 0);
        __syncthreads();
        {
            const LAS bf16* As = mat ? TA : TW;
            f32x16 acc;
#pragma unroll
            for (int j = 0; j < 16; ++j) acc[j] = 0.f;
#pragma unroll
            for (int ks = 0; ks < 4; ++ks) { const bf16x8 a = *(const LAS bf16x8*)(As + (mrt * 32 + lr_) * 72 + ks * 16 + 8 * lh); acc = MFMA32(a, bfr[ks], acc); }
#pragma unroll
            for (int r = 0; r < 16; ++r) { const int tk = mrt * 32 + (r & 3) + 8 * (r >> 2) + 4 * lh; const float z = mbias + acc[r];
                if (mat) AL[tk * 64 + mcc] = sigm(z);
                else { const float sp = fmaxf(-z, 0.f) + __logf(1.f + __expf(-fabsf(z))); Wd[tk * 64 + mcc] = __expf(-__expf(-sp - 0.5f)); } }
        }
        __syncthreads();
        {
            float ss = 0.f, kkv[8];
#pragma unroll
            for (int j = 0; j < 8; ++j) { kkv[j] = k8[j] * kkc[j]; ss += kkv[j] * kkv[j]; }
            ss = red8(ss);
            const float inv = 1.0f / fmaxf(sqrtf(ss), 1e-12f);
            float br = 0.f, kr = 0.f, cs = 0.f;
            const f32x4 al0 = *(const LAS f32x4*)(AL + tok * 64 + c0), al1 = *(const LAS f32x4*)(AL + tok * 64 + c0 + 4), wd0 = *(const LAS f32x4*)(Wd + tok * 64 + c0), wd1 = *(const LAS f32x4*)(Wd + tok * 64 + c0 + 4);
            f32x4 oa[2], ob[2], ok[2], orw[2];
#pragma unroll
            for (int j = 0; j < 8; ++j) { const float al = j < 4 ? al0[j & 3] : al1[j & 3], w = j < 4 ? wd0[j & 3] : wd1[j & 3], kk = kkv[j] * inv, kp = k8[j] * (1.f + (al - 1.f) * kac[j]), bb = kk * al;
                oa[j >> 2][j & 3] = -kk; ob[j >> 2][j & 3] = bb; ok[j >> 2][j & 3] = kp; orw[j >> 2][j & 3] = r8[j] * w;
                br += bb * r8[j]; kr += kp * r8[j]; cs += r8[j] * kp * rrk[j]; }
#pragma unroll
            for (int i = 0; i < 2; ++i) { *(LAS f32x4*)(Aa + tok * 64 + c0 + 4 * i) = oa[i]; *(LAS f32x4*)(Bb + tok * 64 + c0 + 4 * i) = ob[i]; *(LAS f32x4*)(Kp + tok * 64 + c0 + 4 * i) = ok[i]; *(LAS f32x4*)(RW + tok * 64 + c0 + 4 * i) = orw[i]; }
            br = red8(br); kr = red8(kr); cs = red8(cs);
            if (part == 0) { SC[tok * 2] = br; SC[tok * 2 + 1] = kr; if (rg == 0) CTB[(size_t)row * 16 + h] = cs; }
        }
        __syncthreads();
        if (wave < 2) {
            f32x4 a = *(const LAS f32x4*)(Aa + q4), y = *(const LAS f32x4*)(RW + q4), w = *(const LAS f32x4*)(Wd + q4), bb = *(const LAS f32x4*)(Bb + q4), k = *(const LAS f32x4*)(Kp + q4);
            float vv = Vv[ro], brr = SC[0], krr = SC[1];
#pragma unroll 2
            for (int tk = 0; tk < 64; ++tk) {
                const int tn = tk < 63 ? tk + 1 : 63;
                const f32x4 an = *(const LAS f32x4*)(Aa + tn * 64 + q4), yn = *(const LAS f32x4*)(RW + tn * 64 + q4), wn = *(const LAS f32x4*)(Wd + tn * 64 + q4), bn = *(const LAS f32x4*)(Bb + tn * 64 + q4), kn = *(const LAS f32x4*)(Kp + tn * 64 + q4);
                const float vn = Vv[tn * 8 + ro], brn = SC[tn * 2], krn = SC[tn * 2 + 1];
                float psa = (S[0] * a[0] + S[1] * a[1]) + (S[2] * a[2] + S[3] * a[3]);
                float py = (S[0] * y[0] + S[1] * y[1]) + (S[2] * y[2] + S[3] * y[3]);
                const f32x4 u = k * vv, sw = S * w;
                psa = red16(psa); py = red16(py);
                S = sw + (bb * psa + u);
                if (q4 == 0) YB[tk * 8 + ro] = py + psa * brr + vv * krr;
                a = an; y = yn; w = wn; bb = bn; k = kn; vv = vn; brr = brn; krr = krn;
            }
        }
        __syncthreads();
        if (tid < 64) { v4u o; o.x = pk2(YB[tid * 8 + 0], YB[tid * 8 + 1]); o.y = pk2(YB[tid * 8 + 2], YB[tid * 8 + 3]); o.z = pk2(YB[tid * 8 + 4], YB[tid * 8 + 5]); o.w = pk2(YB[tid * 8 + 6], YB[tid * 8 + 7]);
            *(v4u*)(YR + (size_t)(b * T + ch * 64 + tid) * 1024 + vcol) = o; }
    }
}
__device__ __forceinline__ void rwkv_post(const Ptrs& P, LAS unsigned char* lds, int tile, int tid, int wave, int lane) {
    const bf16* RV = (const bf16*)(P.ws + WS_RV); const bf16* LR = (const bf16*)(P.ws + WS_LR); bf16* YR = (bf16*)(P.ws + WS_YR); const float* CTB = (const float*)(P.ws + WS_CT);
    const bf16* G2T = (const bf16*)(P.ws + WS_G2T);
    LAS bf16* SG = (LAS bf16*)lds;
    LAS float* ST = (LAS float*)(lds + 64 * 136 * 2);
    const int tok = tid >> 3, part = tid & 7, row = tile * 64 + tok, t = row & (T - 1);
#pragma unroll
    for (int i = 0; i < 2; ++i) { const int c0 = part * 16 + i * 8; float mu[8], g8[8];
#pragma unroll
        for (int j = 0; j < 8; ++j) mu[j] = P.rmu[3200 + c0 + j];
        shift8(LR, 256, row, t, 128 + c0, mu, g8);
        v4u pg; pg.x = pk2(sigm(g8[0]), sigm(g8[1])); pg.y = pk2(sigm(g8[2]), sigm(g8[3])); pg.z = pk2(sigm(g8[4]), sigm(g8[5])); pg.w = pk2(sigm(g8[6]), sigm(g8[7]));
        *(LAS v4u*)(SG + tok * 136 + c0) = pg; }
#pragma unroll
    for (int i = 0; i < 2; ++i) { const int hd = part * 2 + i; float s = 0.f, s2 = 0.f;
#pragma unroll
        for (int k = 0; k < 8; ++k) { float x8[8]; unpack8(*(const v4u*)(YR + (size_t)row * 1024 + hd * 64 + k * 8), x8);
#pragma unroll
            for (int j = 0; j < 8; ++j) { s += x8[j]; s2 += x8[j] * x8[j]; } }
        const float mean = s * (1.f / 64.f); const float var = fmaxf(s2 * (1.f / 64.f) - mean * mean, 0.f);
        ST[(tok * 16 + hd) * 2] = mean; ST[(tok * 16 + hd) * 2 + 1] = 1.f / sqrtf(var + 64e-5f); }
    __syncthreads();
    const int lr_ = lane & 31, lh = lane >> 5;
    for (int hf = 0; hf < 2; ++hf) {
        f32x16 acc[2][2];
#pragma unroll
        for (int i = 0; i < 2; ++i)
#pragma unroll
            for (int j = 0; j < 2; ++j)
#pragma unroll
                for (int r = 0; r < 16; ++r) acc[i][j][r] = 0.f;
        const int cbase = wave * 128 + hf * 64;
#pragma unroll 2
        for (int ks = 0; ks < 8; ++ks) {
            bf16x8 a[2];
#pragma unroll
            for (int i = 0; i < 2; ++i) a[i] = *(const LAS bf16x8*)(SG + (i * 32 + lr_) * 136 + ks * 16 + 8 * lh);
#pragma unroll
            for (int j = 0; j < 2; ++j) { const bf16x8 bb = *(const bf16x8*)(G2T + (size_t)(cbase + j * 32 + lr_) * 128 + ks * 16 + 8 * lh);
#pragma unroll
                for (int i = 0; i < 2; ++i) acc[i][j] = MFMA32(a[i], bb, acc[i][j]); }
        }
        LAS bf16* GL = (LAS bf16*)(lds + 32768) + wave * (64 * 72);
#pragma unroll
        for (int j = 0; j < 2; ++j)
#pragma unroll
            for (int i = 0; i < 2; ++i)
#pragma unroll
                for (int r = 0; r < 16; ++r) GL[(i * 32 + (r & 3) + 8 * (r >> 2) + 4 * lh) * 72 + j * 32 + lr_] = (bf16)f2bf(acc[i][j][r]);
        asm volatile("s_waitcnt lgkmcnt(0)" ::: "memory");
        const int c8 = (lane & 7) * 8, chn0 = cbase + c8, hd = chn0 >> 6;
        float gg[8], gb[8], muv[8];
#pragma unroll
        for (int j = 0; j < 8; ++j) { gg[j] = P.gng[chn0 + j]; gb[j] = P.gnb[chn0 + j]; muv[j] = P.rmu[2048 + chn0 + j]; }
#pragma unroll 1
        for (int p = 0; p < 8; ++p) { const int tk = p * 8 + (lane >> 3), rw_ = tile * 64 + tk, tt = rw_ & (T - 1);
            float y8[8], v8[8], g8[8]; unpack8(*(const v4u*)(YR + (size_t)rw_ * 1024 + chn0), y8); shift8(RV, 1024, rw_, tt, chn0, muv, v8); unpack8(*(const LAS v4u*)(GL + tk * 72 + c8), g8);
            const float mean = ST[(tk * 16 + hd) * 2], rstd = ST[(tk * 16 + hd) * 2 + 1], ctv = CTB[(size_t)rw_ * 16 + hd];
            float o[8];
#pragma unroll
            for (int j = 0; j < 8; ++j) o[j] = (((y8[j] - mean) * rstd * gg[j] + gb[j]) + ctv * v8[j]) * g8[j];
            v4u w; w.x = pk2(o[0], o[1]); w.y = pk2(o[2], o[3]); w.z = pk2(o[4], o[5]); w.w = pk2(o[6], o[7]);
            *(v4u*)(YR + (size_t)rw_ * 1024 + chn0) = w; }
        asm volatile("s_waitcnt lgkmcnt(0)" ::: "memory");
    }
    __syncthreads();
}

struct Args { Ptrs p; int ph_lo, ph_hi, coop, pad; };
constexpr int N_PHASES = 18;
__global__ void __launch_bounds__(NTHR, 2) mk_fwd(Args args) {
    extern __shared__ __attribute__((aligned(16))) unsigned char lds_raw[];
    LAS unsigned char* lds = (LAS unsigned char*)lds_raw;
    const Ptrs& P = args.p;
    const int tid = threadIdx.x, lane = tid & 63, wave = __builtin_amdgcn_readfirstlane(tid >> 6);
    const int G = gridDim.x, bx = blockIdx.x, gw = bx * NWAVES + wave, NGW = G * NWAVES;
    unsigned char* ws = P.ws;
    bf16* XB = (bf16*)(ws + WS_XB); bf16* HB = (bf16*)(ws + WS_H);
    bf16* BB = (bf16*)(ws + WS_B); bf16* CBf = (bf16*)(ws + WS_C); bf16* DB = (bf16*)(ws + WS_D);
    const int lo = args.ph_lo, hi = args.ph_hi;
#ifndef PH_MASK
#define PH_MASK 0x3FFFF
#endif
#define IN(k) ((((PH_MASK) >> (k)) & 1) && lo <= (k) && (k) < hi)
#ifndef REP_MASK
#define REP_MASK 0
#endif
#define REP(k) for (int rep_ = 0; rep_ < ((((REP_MASK) >> (k)) & 1) + 1); ++rep_)
#define SEAM(k) do { if (IN(k) && IN((k) + 1)) { cg::this_grid().sync(); } } while (0)
    LAS float* scr = (LAS float*)(lds + wave * 16384);

    if (IN(0)) REP(0) {
        conv_mat<1>(P.f1g, P.f1u, FF, D, (bf16*)(ws + WS_WF), 5632, scr, gw, NGW, lane);
        conv_mat<0>(P.f1d, nullptr, D, FF, (bf16*)(ws + WS_WFD), 1024, scr, gw, NGW, lane);
        conv_mat<2>(P.win, nullptr, WIN_LD, D, (bf16*)(ws + WS_WIN1), 3328, scr, gw, NGW, lane);
        conv_mat<3>(P.win, nullptr, WIN_LD, D, (bf16*)(ws + WS_WIN2), 3328, scr, gw, NGW, lane);
        conv_mat<4>(P.win, nullptr, WIN_LD, D, (bf16*)(ws + WS_WIN3), 3072, scr, gw, NGW, lane);
        conv_mat<0>(P.wa, nullptr, D, D, (bf16*)(ws + WS_WA), 1024, scr, gw, NGW, lane);
        conv_mat<0>(P.wb, nullptr, D, D, (bf16*)(ws + WS_WB), 1024, scr, gw, NGW, lane);
        conv_mat<0>(P.wo, nullptr, D, D, (bf16*)(ws + WS_WO), 1024, scr, gw, NGW, lane);
        conv_mat<0>(P.rw2, nullptr, D, 64, (bf16*)(ws + WS_W2T), 1024, scr, gw, NGW, lane);
        conv_mat<0>(P.ra2, nullptr, D, 64, (bf16*)(ws + WS_A2T), 1024, scr, gw, NGW, lane);
        conv_mat<0>(P.rg2, nullptr, D, 128, (bf16*)(ws + WS_G2T), 1024, scr, gw, NGW, lane);
        cvt_rows_bf16(P.x, XB, gw, NGW, lane);
    }
    SEAM(0);
    if (IN(1)) REP(1) { pg8::Gemm g{XB, (const bf16*)(ws + WS_WF), M, 5632, D}; pg8::StaticOrder S; S.init(M, 5632, G, bx); pg8::EpiSwiGLU E{HB, FF};
        pg8::gemm_phase<pg8::EpiSwiGLU, pg8::StaticOrder, true, true>(lds, g, S, E); }
    SEAM(1);
    if (IN(2)) { pg8::Gemm g{HB, (const bf16*)(ws + WS_WFD), M, D, FF}; pg8::StaticOrder S; S.init(M, D, G, bx); pg8::EpiResid E{P.x, P.out, D, ALPHA, 0.5f};
        pg8::gemm_phase<pg8::EpiResid, pg8::StaticOrder, true, true>(lds, g, S, E); }
    SEAM(2);
    if (IN(3)) {
        ln_rows(P.out, P.ln1g, P.ln1b, P.out, XB, gw, NGW, lane);
        conv_mat<1>(P.f2g, P.f2u, FF, D, (bf16*)(ws + WS_WF), 5632, scr, gw, NGW, lane);
        conv_mat<0>(P.f2d, nullptr, D, FF, (bf16*)(ws + WS_WFD), 1024, scr, gw, NGW, lane);
    }
    SEAM(3);
    if (IN(4)) REP(4) { pg8::Gemm g{XB, (const bf16*)(ws + WS_WIN1), M, 3328, D}; pg8::StaticOrder S; S.init(M, 3328, G, bx);
        typedef pg8::EpiSplit<0, (long)(WS_C - WS_B) / 2, (long)(WS_D - WS_B) / 2> EP; EP E{BB, nullptr, (float*)(ws + WS_GATES), P.ib, P.fb};
        pg8::gemm_phase<EP, pg8::StaticOrder, true, true>(lds, g, S, E); }
    SEAM(4);
    if (IN(5)) REP(5) { for (int u = bx; u < 512; u += G) mlstm_passA(P, lds, u, tid, wave, lane); }
    SEAM(5);
    if (IN(6)) { mlstm_passB(P, bx * NTHR + tid, G * NTHR); }
    SEAM(6);
    if (IN(7)) { for (int u = bx; u < 512; u += G) mlstm_passC(P, lds, u, tid, wave, lane); }
    SEAM(7);
    if (IN(8)) REP(8) { pg8::Gemm g{XB, (const bf16*)(ws + WS_WIN2), M, 3328, D}; pg8::StaticOrder S; S.init(M, 3328, G, bx);
        typedef pg8::EpiSplit<1, (long)(WS_C - WS_B) / 2, (long)(WS_RV - WS_B) / 2> EP; EP E{BB, (bf16*)(ws + WS_LR), nullptr, nullptr, nullptr};
        pg8::gemm_phase<EP, pg8::StaticOrder, true, true>(lds, g, S, E); }
    SEAM(8);
    if (IN(9)) REP(9) { for (int u = bx; u < 256; u += G) rwkv_unit(P, lds, u, tid, wave, lane); }
    SEAM(9);
    if (IN(10)) { for (int u = bx; u < M / 64; u += G) rwkv_post(P, lds, u, tid, wave, lane); }
    SEAM(10);
    if (IN(11)) { pg8::Gemm g{XB, (const bf16*)(ws + WS_WIN3), M, 3072, D}; pg8::StaticOrder S; S.init(M, 3072, G, bx);
        typedef pg8::EpiSplit<2, -(long)(WS_D - WS_C) / 2, -(long)(WS_D - WS_B) / 2> EP; EP E{DB, nullptr, nullptr, nullptr, nullptr};
        pg8::gemm_phase<EP, pg8::StaticOrder, true, true>(lds, g, S, E); }
    SEAM(11);
    if (IN(12)) {
        { pg8::Gemm g{DB, (const bf16*)(ws + WS_WA), M, D, D}; pg8::StaticOrder S; S.init(M, D, G, bx); pg8::EpiBranch<false> E{CBf, nullptr};
          pg8::gemm_phase<pg8::EpiBranch<false>, pg8::StaticOrder, true, true>(lds, g, S, E); }
        __syncthreads();
        { pg8::Gemm g{(const bf16*)(ws + WS_YR), (const bf16*)(ws + WS_WB), M, D, D}; pg8::StaticOrder S; S.init(M, D, G, bx); pg8::EpiBranch<true> E{BB, CBf};
          pg8::gemm_phase<pg8::EpiBranch<true>, pg8::StaticOrder, true, true>(lds, g, S, E); }
    }
    SEAM(12);
    if (IN(13)) { pg8::Gemm g{BB, (const bf16*)(ws + WS_WO), M, D, D}; pg8::StaticOrder S; S.init(M, D, G, bx); pg8::EpiResid E{P.out, P.out, D, ALPHA, 1.0f};
        pg8::gemm_phase<pg8::EpiResid, pg8::StaticOrder, true, true>(lds, g, S, E); }
    SEAM(13);
    if (IN(14)) { ln_rows(P.out, P.ln2g, P.ln2b, P.out, XB, gw, NGW, lane); }
    SEAM(14);
    if (IN(15)) { pg8::Gemm g{XB, (const bf16*)(ws + WS_WF), M, 5632, D}; pg8::StaticOrder S; S.init(M, 5632, G, bx); pg8::EpiSwiGLU E{HB, FF};
        pg8::gemm_phase<pg8::EpiSwiGLU, pg8::StaticOrder, true, true>(lds, g, S, E); }
    SEAM(15);
    if (IN(16)) { pg8::Gemm g{HB, (const bf16*)(ws + WS_WFD), M, D, FF}; pg8::StaticOrder S; S.init(M, D, G, bx); pg8::EpiResid E{P.out, P.out, D, ALPHA, 0.5f};
        pg8::gemm_phase<pg8::EpiResid, pg8::StaticOrder, true, true>(lds, g, S, E); }
    SEAM(16);
    if (IN(17)) { ln_rows(P.out, P.ln3g, P.ln3b, P.out, nullptr, gw, NGW, lane); }
#undef IN
#undef SEAM
}

#ifndef MK_N_LAUNCHES
#define MK_N_LAUNCHES 1
#endif
extern "C" void kernel_launch(void* const* d_in, const int* in_sizes, int n_in, void* d_out, int out_size, void* d_ws, size_t ws_size, hipStream_t stream) {
    static int grid = 0;
    if (grid == 0) {
        int dev = 0, cus = 0, per_cu = 0;
        hipGetDevice(&dev); hipDeviceGetAttribute(&cus, hipDeviceAttributeMultiprocessorCount, dev);
        hipFuncSetAttribute((const void*)mk_fwd, hipFuncAttributeMaxDynamicSharedMemorySize, LDS_BYTES);
        hipOccupancyMaxActiveBlocksPerMultiprocessor(&per_cu, (const void*)mk_fwd, NTHR, LDS_BYTES);
        if (per_cu < 1) { fprintf(stderr, "kernel_launch: occupancy query reports %d blocks per CU\n", per_cu); per_cu = 1; }
        grid = cus;
        if (n_in != 33 || ws_size < WS_END) fprintf(stderr, "kernel_launch: unexpected n_in %d / ws_size %zu\n", n_in, ws_size);
        (void)hipGetLastError();
    }
    Args a{};
    const float** pp = (const float**)&a.p;
    for (int i = 0; i < 33; ++i) pp[i] = (const float*)d_in[i];
    a.p.out = (float*)d_out; a.p.ws = (unsigned char*)d_ws;
    if (MK_N_LAUNCHES == 1) {
        a.ph_lo = 0; a.ph_hi = N_PHASES; a.coop = 1;
        void* kargs[] = {&a};
        hipError_t e = hipLaunchCooperativeKernel((const void*)mk_fwd, dim3(grid), dim3(NTHR), kargs, LDS_BYTES, stream);
        if (e != hipSuccess) fprintf(stderr, "cooperative launch failed: %s (grid %d)\n", hipGetErrorString(e), grid);
    } else {
        for (int ph = 0; ph < N_PHASES; ++ph) { a.ph_lo = ph; a.ph_hi = ph + 1; a.coop = 0; hipLaunchKernelGGL(mk_fwd, dim3(grid), dim3(NTHR), LDS_BYTES, stream, a); }
    }
}
```

```cpp
#include <hip/hip_runtime.h>
#include <hip/hip_cooperative_groups.h>
#include <cstdio>
#include <cstdint>
namespace cg = cooperative_groups;
namespace pg8 {
#define PG8_LAS __attribute__((address_space(3)))
typedef unsigned short bf16_t;
typedef short bf16x8 __attribute__((ext_vector_type(8)));
typedef float f32x4 __attribute__((ext_vector_type(4)));
typedef unsigned u32x4 __attribute__((ext_vector_type(4)));
constexpr int BM = 256, BK = 64, HALF = 128, HTB = HALF * BK * 2  , STAGE_BYTES = 8 * HTB, NXCD = 8, WGM = 8;

__host__ __device__ __forceinline__ int lds_byte(int r, int c) { const int st = (r >> 4) * 2 + (c >> 5), rr = r & 15, cc = c & 31, ob = rr * 64 + cc * 2; return st * 1024 + (ob ^ (((ob >> 9) & 1) << 5)); }
__host__ __device__ __forceinline__ void stage_rc(int b, int& R, int& C) { const int st = b / 1024, sb = b % 1024, swz = sb ^ (((sb >> 9) & 1) << 5); R = (st >> 1) * 16 + swz / 64; C = (st & 1) * 32 + (swz % 64) / 2; }
__host__ __device__ __forceinline__ int perm32(int rho) { const int n = rho >> 4, i = rho & 15; return 8 * (i >> 2) + 4 * n + (i & 3); }

struct Unit { int pm, pn; };
struct Gemm { const bf16_t* A; const bf16_t* Bt; int M, N, K; };

struct StaticOrder {
    int nM, nN, nwg, G, c;
    __host__ __device__ void init(int M, int N, int G_, int c_) { nM = M / BM; nN = N / BM; nwg = nM * nN; G = G_; c = c_; }
    __host__ __device__ bool next(int i, Unit& u) const {
        const long L = (long)i * G + c; if (L >= nwg) return false;
        int wgid = (int)L; { const int q = nwg / NXCD, r = nwg % NXCD, xcd = wgid % NXCD, off = wgid / NXCD; wgid = (xcd < r ? xcd * (q + 1) : r * (q + 1) + (xcd - r) * q) + off; }
        const int nig = WGM * nN, gid = wgid / nig, fm = gid * WGM, gsz = (nM - fm) < WGM ? (nM - fm) : WGM;
        u.pm = fm + ((wgid % nig) % gsz); u.pn = (wgid % nig) / gsz; return true;
    }
    __device__ __forceinline__ void a_ready(const Unit&) const {}
    __device__ __forceinline__ void done(const Unit&) const {}
};

__device__ __forceinline__ unsigned cvt_pk_bf16(float lo, float hi) { unsigned r; asm volatile("v_cvt_pk_bf16_f32 %0, %1, %2" : "=v"(r) : "v"(lo), "v"(hi)); return r; }
__device__ __forceinline__ float bf_lo(unsigned w) { return __uint_as_float(w << 16); }
__device__ __forceinline__ float bf_hi(unsigned w) { return __uint_as_float(w & 0xffff0000u); }
__device__ __forceinline__ float sigmoidf_(float x) { return 1.0f / (1.0f + __expf(-x)); }
__device__ __forceinline__ float siluf_(float x) { return x / (1.0f + __expf(-x)); }

struct EpiSwiGLU {
    static constexpr bool PERM = true, AFTER_DRAIN = false;
    bf16_t* H; int ldh;
    __device__ __forceinline__ void operator()(const f32x4 (&acc)[2][2][4][2], const Unit& u, int wr, int wc, int fr, int fq) const {
        const int row0 = u.pm * BM + wr * 64 + fr, col0 = u.pn * 128 + wc * 32 + 8 * fq;
#pragma unroll
        for (int ai = 0; ai < 2; ++ai)
#pragma unroll
            for (int m = 0; m < 4; ++m) {
                bf16_t* rowp = H + (size_t)(row0 + ai * HALF + m * 16) * ldh + col0;
                const f32x4 g0 = acc[ai][0][m][0], g1 = acc[ai][0][m][1], u0 = acc[ai][1][m][0], u1 = acc[ai][1][m][1];
                u32x4 w;
                w.x = cvt_pk_bf16(siluf_(g0[0]) * u0[0], siluf_(g0[1]) * u0[1]); w.y = cvt_pk_bf16(siluf_(g0[2]) * u0[2], siluf_(g0[3]) * u0[3]);
                w.z = cvt_pk_bf16(siluf_(g1[0]) * u1[0], siluf_(g1[1]) * u1[1]); w.w = cvt_pk_bf16(siluf_(g1[2]) * u1[2], siluf_(g1[3]) * u1[3]);
                *(u32x4*)rowp = w;
            }
    }
};
struct EpiResid {
    static constexpr bool PERM = false, AFTER_DRAIN = false;
    const float* res; float* out; int ldc; float alpha, scale;
    __device__ __forceinline__ void operator()(const f32x4 (&acc)[2][2][4][2], const Unit& u, int wr, int wc, int fr, int fq) const {
        const int row0 = u.pm * BM + wr * 64 + fr, col0 = u.pn * BM + wc * 32 + 4 * fq;
#pragma unroll
        for (int ai = 0; ai < 2; ++ai)
#pragma unroll
            for (int m = 0; m < 4; ++m) {
                const size_t off = (size_t)(row0 + ai * HALF + m * 16) * ldc + col0;
#pragma unroll
                for (int bj = 0; bj < 2; ++bj)
#pragma unroll
                    for (int n = 0; n < 2; ++n) {
                        const f32x4 r = *(const f32x4*)(res + off + bj * HALF + n * 16);
                        *(f32x4*)(out + off + bj * HALF + n * 16) = r * alpha + acc[ai][bj][m][n] * scale;
                    }
            }
    }
};
template <int MODE, long OFF1, long OFF2> struct EpiSplit {
    static constexpr bool PERM = true, AFTER_DRAIN = false;
    bf16_t* buf0; bf16_t* buf3; float* gates; const float* ib; const float* fb;
    __device__ __forceinline__ void operator()(const f32x4 (&acc)[2][2][4][2], const Unit& u, int wr, int wc, int fr, int fq) const {
        const int grp = u.pn >> 2, row0 = u.pm * BM + wr * 64 + fr;
        if (grp == 3) {
            if (MODE == 0) {
                if (wc == 0 && fq == 0) {
                    const f32x4 bi = *(const f32x4*)ib, bf = *(const f32x4*)fb;
#pragma unroll
                    for (int ai = 0; ai < 2; ++ai)
#pragma unroll
                        for (int m = 0; m < 4; ++m) {
                            float* g = gates + (size_t)(row0 + ai * HALF + m * 16) * 8;
                            const f32x4 vi = acc[ai][0][m][0] + bi; f32x4 vf = acc[ai][0][m][1] + bf;
#pragma unroll
                            for (int j = 0; j < 4; ++j) { const float x = vf[j]; vf[j] = fminf(x, 0.f) - log1pf(__expf(-fabsf(x))); }
                            *(f32x4*)g = vi; *(f32x4*)(g + 4) = vf;
                        }
                }
            } else if (MODE == 1) {
                const int col0 = wc * 32 + 8 * fq;
#pragma unroll
                for (int ai = 0; ai < 2; ++ai)
#pragma unroll
                    for (int m = 0; m < 4; ++m) { bf16_t* rowp = buf3 + (size_t)(row0 + ai * HALF + m * 16) * 256 + col0;
#pragma unroll
                        for (int bj = 0; bj < 2; ++bj) { const f32x4 v0 = acc[ai][bj][m][0], v1 = acc[ai][bj][m][1]; u32x4 w;
                            w.x = cvt_pk_bf16(v0[0], v0[1]); w.y = cvt_pk_bf16(v0[2], v0[3]); w.z = cvt_pk_bf16(v1[0], v1[1]); w.w = cvt_pk_bf16(v1[2], v1[3]);
                            *(u32x4*)(rowp + bj * HALF) = w; } }
            }
            return;
        }
        bf16_t* base = buf0 + (grp == 0 ? 0L : (grp == 1 ? OFF1 : OFF2));
        const int col0 = (u.pn & 3) * BM + wc * 32 + 8 * fq;
#pragma unroll
        for (int ai = 0; ai < 2; ++ai)
#pragma unroll
            for (int m = 0; m < 4; ++m) { bf16_t* rowp = base + (size_t)(row0 + ai * HALF + m * 16) * 1024 + col0;
#pragma unroll
                for (int bj = 0; bj < 2; ++bj) { f32x4 v0 = acc[ai][bj][m][0], v1 = acc[ai][bj][m][1];
                    if (MODE == 2) {
#pragma unroll
                        for (int j = 0; j < 4; ++j) { v0[j] = sigmoidf_(v0[j]); v1[j] = sigmoidf_(v1[j]); }
                        if (grp == 0) { const u32x4 o = *(const u32x4*)(rowp + bj * HALF);
                            v0[0] *= bf_lo(o.x); v0[1] *= bf_hi(o.x); v0[2] *= bf_lo(o.y); v0[3] *= bf_hi(o.y);
                            v1[0] *= bf_lo(o.z); v1[1] *= bf_hi(o.z); v1[2] *= bf_lo(o.w); v1[3] *= bf_hi(o.w); }
                    }
                    u32x4 w; w.x = cvt_pk_bf16(v0[0], v0[1]); w.y = cvt_pk_bf16(v0[2], v0[3]); w.z = cvt_pk_bf16(v1[0], v1[1]); w.w = cvt_pk_bf16(v1[2], v1[3]);
                    *(u32x4*)(rowp + bj * HALF) = w; } }
    }
};
template <bool SECOND> struct EpiBranch {
    static constexpr bool PERM = true, AFTER_DRAIN = false;
    bf16_t* G; const bf16_t* T1;
    __device__ __forceinline__ void operator()(const f32x4 (&acc)[2][2][4][2], const Unit& u, int wr, int wc, int fr, int fq) const {
        const int row0 = u.pm * BM + wr * 64 + fr, col0 = u.pn * BM + wc * 32 + 8 * fq;
#pragma unroll
        for (int ai = 0; ai < 2; ++ai)
#pragma unroll
            for (int m = 0; m < 4; ++m) { const size_t off = (size_t)(row0 + ai * HALF + m * 16) * 1024 + col0;
#pragma unroll
                for (int bj = 0; bj < 2; ++bj) { const f32x4 a0 = acc[ai][bj][m][0], a1 = acc[ai][bj][m][1];
                    const u32x4 g = *(const u32x4*)(G + off + bj * HALF);
                    float r[8] = { bf_lo(g.x) * a0[0], bf_hi(g.x) * a0[1], bf_lo(g.y) * a0[2], bf_hi(g.y) * a0[3], bf_lo(g.z) * a1[0], bf_hi(g.z) * a1[1], bf_lo(g.w) * a1[2], bf_hi(g.w) * a1[3] };
                    if (SECOND) { const u32x4 t = *(const u32x4*)(T1 + off + bj * HALF);
                        r[0] += bf_lo(t.x); r[1] += bf_hi(t.x); r[2] += bf_lo(t.y); r[3] += bf_hi(t.y); r[4] += bf_lo(t.z); r[5] += bf_hi(t.z); r[6] += bf_lo(t.w); r[7] += bf_hi(t.w); }
                    u32x4 w; w.x = cvt_pk_bf16(r[0], r[1]); w.y = cvt_pk_bf16(r[2], r[3]); w.z = cvt_pk_bf16(r[4], r[5]); w.w = cvt_pk_bf16(r[6], r[7]);
                    *(u32x4*)(G + off + bj * HALF) = w; } }
    }
};

template <class Epi, class Sched, bool ALIGN_EPI = false, bool SP2 = false>
__device__ __forceinline__ void gemm_phase(PG8_LAS unsigned char* lds, const Gemm g, const Sched& S, const Epi& E) {
    const int tid = threadIdx.x, wid = __builtin_amdgcn_readfirstlane(tid >> 6), lane = tid & 63, wr = wid >> 2, wc = wid & 3, fr = lane & 15, fq = lane >> 4;
    const int K = g.K, nt = K / BK;
    unsigned voffA[2], voffB[2];
#pragma unroll
    for (int i = 0; i < 2; ++i) { int R, C; stage_rc(tid * 16 + i * 8192, R, C); const int Rb = Epi::PERM ? ((R & ~31) + perm32(R & 31)) : R;
        voffA[i] = (unsigned)(R * K + C) * 2u; voffB[i] = (unsigned)(Rb * K + C) * 2u; }
    const size_t kstep = (size_t)(BK * 2);
    const size_t hstep = (size_t)HALF * K * 2;
    const size_t tstep = 2 * hstep;
    const unsigned ldsw = (unsigned)wid * 1024u;
    const int aoff = lds_byte(wr * 64 + fr, fq * 8), boff = lds_byte(wc * 32 + fr, fq * 8);
#define PG8_SA(b, h) (((b) * 2 + (h)) * HTB)
#define PG8_SB(b, h) ((4 + (b) * 2 + (h)) * HTB)
#define PG8_STAGE(bufoff, gbase, voff) do { _Pragma("unroll") for (int _i = 0; _i < 2; ++_i) \
        __builtin_amdgcn_global_load_lds((const unsigned*)((const char*)(gbase) + (voff)[_i]), (PG8_LAS unsigned*)(lds + (bufoff) + ldsw + _i * 8192), 16, 0, 0); } while (0)
#define PG8_LDA(dst, b, h) do { _Pragma("unroll") for (int m = 0; m < 4; ++m) _Pragma("unroll") for (int k = 0; k < 2; ++k) dst[m][k] = *(const PG8_LAS bf16x8*)(lds + PG8_SA(b, h) + aoff + m * 2048 + k * 1024); } while (0)
#define PG8_LDB(dst, b, h) do { _Pragma("unroll") for (int n = 0; n < 2; ++n) _Pragma("unroll") for (int k = 0; k < 2; ++k) dst[n][k] = *(const PG8_LAS bf16x8*)(lds + PG8_SB(b, h) + boff + n * 2048 + k * 1024); } while (0)
#define PG8_MMA(ai, bj, At, Bt) do { __builtin_amdgcn_s_setprio(1); _Pragma("unroll") for (int m = 0; m < 4; ++m) _Pragma("unroll") for (int n = 0; n < 2; ++n) _Pragma("unroll") for (int k = 0; k < 2; ++k) \
        acc[ai][bj][m][n] = __builtin_amdgcn_mfma_f32_16x16x32_bf16(Bt[n][k], At[m][k], acc[ai][bj][m][n], 0, 0, 0); __builtin_amdgcn_s_setprio(0); } while (0)
#define PG8_WAIT_V(n) asm volatile("s_waitcnt vmcnt(" #n ")" ::: "memory")
#define PG8_WAIT_L(n) asm volatile("s_waitcnt lgkmcnt(" #n ")" ::: "memory")
#define PG8_BAR __builtin_amdgcn_s_barrier()
#define PG8_SCHED __builtin_amdgcn_sched_barrier(0)
    Unit cur, nxt; int ui = 0;
    if (!S.next(0, cur)) return;
    f32x4 acc[2][2][4][2];
#pragma unroll
    for (int a = 0; a < 2; ++a)
#pragma unroll
        for (int b = 0; b < 2; ++b)
#pragma unroll
            for (int m = 0; m < 4; ++m)
#pragma unroll
                for (int n = 0; n < 2; ++n) acc[a][b][m][n] = (f32x4){0.f, 0.f, 0.f, 0.f};
    bf16x8 At[4][2], B0[2][2], B1[2][2];
    const char* cA = (const char*)g.A + (size_t)cur.pm * tstep; const char* cB = (const char*)g.Bt + (size_t)cur.pn * tstep;
    S.a_ready(cur);
    if constexpr (SP2) {
        PG8_STAGE(PG8_SB(0, 0), cB, voffB); PG8_STAGE(PG8_SB(0, 1), cB + hstep, voffB); PG8_STAGE(PG8_SA(0, 0), cA, voffA); PG8_STAGE(PG8_SA(0, 1), cA + hstep, voffA);
        if (wr == 1) PG8_BAR;
        PG8_WAIT_V(2); PG8_BAR;
        PG8_STAGE(PG8_SB(1, 0), cB + kstep, voffB); PG8_STAGE(PG8_SA(1, 0), cA + kstep, voffA); PG8_STAGE(PG8_SB(1, 1), cB + hstep + kstep, voffB);
        PG8_WAIT_V(6); PG8_BAR;
    } else {
        PG8_STAGE(PG8_SB(0, 0), cB, voffB); PG8_STAGE(PG8_SA(0, 0), cA, voffA); PG8_STAGE(PG8_SB(0, 1), cB + hstep, voffB); PG8_STAGE(PG8_SA(0, 1), cA + hstep, voffA);
        if (wr == 1) PG8_BAR;
        PG8_WAIT_V(4); PG8_BAR;
        PG8_STAGE(PG8_SB(1, 0), cB + kstep, voffB); PG8_STAGE(PG8_SA(1, 0), cA + kstep, voffA); PG8_STAGE(PG8_SB(1, 1), cB + hstep + kstep, voffB);
        PG8_WAIT_V(6); PG8_BAR;
    }
    for (;;) {
        const bool has_next = S.next(ui + 1, nxt);
        const char* nA = has_next ? (const char*)g.A + (size_t)nxt.pm * tstep : cA; const char* nB = has_next ? (const char*)g.Bt + (size_t)nxt.pn * tstep : cB;
        for (int t = 0; t < nt; t += 2) {
            const bool last = (t == nt - 2);
            const char* a1 = cA + (size_t)(t + 1) * kstep;
            const char* a2 = last ? nA : cA + (size_t)(t + 2) * kstep; const char* b2 = last ? nB : cB + (size_t)(t + 2) * kstep;
            const char* a3 = a2 + kstep; const char* b3 = b2 + kstep;
            if (last && has_next) S.a_ready(nxt);
            if constexpr (SP2) {
            PG8_LDB(B0, 0, 0); PG8_LDB(B1, 0, 1); PG8_SCHED; PG8_LDA(At, 0, 0); PG8_STAGE(PG8_SA(1, 1), a1 + hstep, voffA);
            PG8_WAIT_V(8); PG8_WAIT_L(0); PG8_BAR; PG8_MMA(0, 0, At, B0); PG8_MMA(0, 1, At, B1); PG8_BAR; PG8_SCHED;
            PG8_LDA(At, 0, 1); PG8_STAGE(PG8_SB(0, 0), b2, voffB); PG8_STAGE(PG8_SB(0, 1), b2 + hstep, voffB); PG8_STAGE(PG8_SA(0, 0), a2, voffA);
            PG8_WAIT_V(8); PG8_WAIT_L(0); PG8_BAR; PG8_MMA(1, 0, At, B0); PG8_MMA(1, 1, At, B1); PG8_BAR; PG8_SCHED;
            PG8_LDB(B0, 1, 0); PG8_LDB(B1, 1, 1); PG8_SCHED; PG8_LDA(At, 1, 0); PG8_STAGE(PG8_SA(0, 1), a2 + hstep, voffA);
            PG8_WAIT_V(8); PG8_WAIT_L(0); PG8_BAR; PG8_MMA(0, 0, At, B0); PG8_MMA(0, 1, At, B1); PG8_BAR; PG8_SCHED;
            PG8_LDA(At, 1, 1); PG8_STAGE(PG8_SB(1, 0), b3, voffB); PG8_STAGE(PG8_SB(1, 1), b3 + hstep, voffB); PG8_STAGE(PG8_SA(1, 0), a3, voffA);
            PG8_WAIT_V(8); PG8_WAIT_L(0); PG8_BAR; PG8_MMA(1, 0, At, B0); PG8_MMA(1, 1, At, B1); PG8_BAR; PG8_SCHED;
            } else {
            PG8_LDB(B0, 0, 0); PG8_SCHED; PG8_LDA(At, 0, 0); PG8_STAGE(PG8_SA(1, 1), a1 + hstep, voffA);
            PG8_WAIT_L(8); PG8_BAR; PG8_WAIT_L(0); PG8_MMA(0, 0, At, B0); PG8_BAR; PG8_SCHED;
            PG8_LDB(B1, 0, 1); PG8_STAGE(PG8_SB(0, 0), b2, voffB);
            PG8_BAR; PG8_WAIT_L(0); PG8_MMA(0, 1, At, B1); PG8_BAR;
            PG8_LDA(At, 0, 1); PG8_STAGE(PG8_SA(0, 0), a2, voffA);
            PG8_BAR; PG8_WAIT_L(0); PG8_MMA(1, 0, At, B0); PG8_BAR; PG8_SCHED;
            PG8_STAGE(PG8_SB(0, 1), b2 + hstep, voffB);
            PG8_WAIT_V(6); PG8_BAR; PG8_MMA(1, 1, At, B1); PG8_BAR;
            PG8_LDB(B0, 1, 0); PG8_SCHED; PG8_LDA(At, 1, 0); PG8_STAGE(PG8_SA(0, 1), a2 + hstep, voffA);
            PG8_WAIT_L(8); PG8_BAR; PG8_WAIT_L(0); PG8_MMA(0, 0, At, B0); PG8_BAR; PG8_SCHED;
            PG8_LDB(B1, 1, 1); PG8_STAGE(PG8_SB(1, 0), b3, voffB);
            PG8_BAR; PG8_WAIT_L(0); PG8_MMA(0, 1, At, B1); PG8_BAR;
            PG8_LDA(At, 1, 1); PG8_STAGE(PG8_SA(1, 0), a3, voffA);
            PG8_BAR; PG8_WAIT_L(0); PG8_MMA(1, 0, At, B0); PG8_BAR; PG8_SCHED;
            PG8_STAGE(PG8_SB(1, 1), b3 + hstep, voffB);
            PG8_WAIT_V(6); PG8_BAR; PG8_MMA(1, 1, At, B1); PG8_BAR;
            }
        }
        if constexpr (ALIGN_EPI) { if (wr == 0) PG8_BAR; }
        if constexpr (!Epi::AFTER_DRAIN) { E(acc, cur, wr, wc, fr, fq); S.done(cur); }
        if (!has_next) break;
#pragma unroll
        for (int a = 0; a < 2; ++a)
#pragma unroll
            for (int b = 0; b < 2; ++b)
#pragma unroll
                for (int m = 0; m < 4; ++m)
#pragma unroll
                    for (int n = 0; n < 2; ++n) acc[a][b][m][n] = (f32x4){0.f, 0.f, 0.f, 0.f};
        cur = nxt; cA = nA; cB = nB; ++ui;
        if constexpr (ALIGN_EPI) { if (wr == 1) PG8_BAR; }
    }
    PG8_WAIT_V(0);
    if constexpr (!ALIGN_EPI) { if (wr == 0) PG8_BAR; }
    PG8_BAR;
    if constexpr (Epi::AFTER_DRAIN) { E.fused(acc, cur, wr, wc, fr, fq, lds, wid, lane); S.done(cur); }
#undef PG8_SA
#undef PG8_SB
#undef PG8_STAGE
#undef PG8_LDA
#undef PG8_LDB
#undef PG8_MMA
#undef PG8_WAIT_V
#undef PG8_WAIT_L
#undef PG8_BAR
#undef PG8_SCHED
}
}

constexpr int NWAVES = 8, NTHR = 512;
constexpr int BATCH = 2, T = 8192, D = 1024, FF = 2816, M = BATCH * T;
constexpr int WIN_LD = 9480;
constexpr float ALPHA = 1.189207115002721f;
constexpr size_t MiB = 1u << 20;
constexpr size_t WS_GATES = 1 * MiB;
constexpr size_t WS_CT = WS_GATES + 512 * 1024;
constexpr size_t WS_NLOC = WS_CT + 1 * MiB;
constexpr size_t WS_GC = WS_NLOC + 512 * 1024;
constexpr size_t WS_W2T = WS_GC + 64 * 1024;
constexpr size_t WS_A2T = WS_W2T + 128 * 1024;
constexpr size_t WS_G2T = WS_A2T + 128 * 1024;
constexpr size_t WS_WIN1 = 4 * MiB;
constexpr size_t WS_WIN2 = WS_WIN1 + 6656 * 1024;
constexpr size_t WS_WIN3 = WS_WIN2 + 6656 * 1024;
constexpr size_t WS_WA = 23 * MiB, WS_WB = 25 * MiB, WS_WO = 27 * MiB;
constexpr size_t WS_WF = 29 * MiB;
constexpr size_t WS_WFD = 40 * MiB;
constexpr size_t WS_XB = 46 * MiB;
constexpr size_t WS_B = 78 * MiB, WS_C = 110 * MiB, WS_D = 142 * MiB, WS_E = 174 * MiB;
constexpr size_t WS_H = WS_B;
constexpr size_t WS_RV = WS_E, WS_LR = WS_E + 32 * MiB, WS_YR = WS_E + 40 * MiB;
constexpr size_t WS_END = WS_YR + 32 * MiB;
static_assert(WS_G2T + 256 * 1024 <= WS_WIN1 && WS_WIN3 + 6 * MiB <= WS_WA && WS_WFD + 5632 * 1024 <= WS_XB && WS_H + (size_t)M * FF * 2 <= WS_E && WS_END <= 256 * MiB, "ws map");
constexpr int LDS_BYTES = 147456;

#define LAS __attribute__((address_space(3)))
typedef unsigned short bf16;
typedef unsigned v4u __attribute__((ext_vector_type(4)));
typedef float f32x4 __attribute__((ext_vector_type(4)));
typedef float f32x16 __attribute__((ext_vector_type(16)));
typedef short bf16x8 __attribute__((ext_vector_type(8)));
__device__ __forceinline__ unsigned f2bf(float f) { unsigned u = __builtin_bit_cast(unsigned, f); return (u + 0x7fffu + ((u >> 16) & 1u)) >> 16; }
__device__ __forceinline__ unsigned pk2(float lo, float hi) { return pg8::cvt_pk_bf16(lo, hi); }
__device__ __forceinline__ float bfl(unsigned w) { return __uint_as_float(w << 16); }
__device__ __forceinline__ float bfh(unsigned w) { return __uint_as_float(w & 0xffff0000u); }
__device__ __forceinline__ float bf1(bf16 h) { return __uint_as_float((unsigned)h << 16); }
__device__ __forceinline__ void unpack8(const v4u w, float (&o)[8]) { o[0] = bfl(w.x); o[1] = bfh(w.x); o[2] = bfl(w.y); o[3] = bfh(w.y); o[4] = bfl(w.z); o[5] = bfh(w.z); o[6] = bfl(w.w); o[7] = bfh(w.w); }
__device__ __forceinline__ float sigm(float x) { return 1.0f / (1.0f + __expf(-x)); }
__device__ __forceinline__ float wave_sum(float v) {
#pragma unroll
    for (int o = 1; o < 64; o <<= 1) v += __shfl_xor(v, o);
    return v;
}
#define MFMA32(a, b, c) __builtin_amdgcn_mfma_f32_32x32x16_bf16(a, b, c, 0, 0, 0)

struct Ptrs {
    const float* x; const float *f1g, *f1u, *f1d, *ln1g, *ln1b, *win, *cw, *cb, *ib, *fb, *mng, *rmu, *rw0, *rw2, *ra0, *ra2, *rg2, *rkk, *rka, *rrk, *gng, *gnb, *wa, *wb, *wo, *ln2g, *ln2b, *f2g, *f2u, *f2d, *ln3g, *ln3b;
    float* out; unsigned char* ws;
};

__device__ __forceinline__ void tr_item(const float* W, int ldw, int K, int src_col0, int nvalid, bf16* WT, int dst_row0, int k0, LAS float* scr, int lane) {
    const int n_ = lane & 31;
#pragma unroll 8
    for (int i = 0; i < 32; ++i) { const int kk = 2 * i + (lane >> 5); scr[kk * 33 + n_] = (n_ < nvalid) ? W[(size_t)(k0 + kk) * ldw + src_col0 + n_] : 0.f; }
    asm volatile("s_waitcnt lgkmcnt(0)" ::: "memory");
    const int c = lane & 7;
#pragma unroll
    for (int j = 0; j < 4; ++j) { const int n = (lane >> 3) + 8 * j; const LAS float* s = scr + (8 * c) * 33 + n;
        v4u o; o.x = pk2(s[0 * 33], s[1 * 33]); o.y = pk2(s[2 * 33], s[3 * 33]); o.z = pk2(s[4 * 33], s[5 * 33]); o.w = pk2(s[6 * 33], s[7 * 33]);
        *(v4u*)(WT + (size_t)(dst_row0 + n) * K + k0 + 8 * c) = o; }
    asm volatile("s_waitcnt lgkmcnt(0)" ::: "memory");
}
template <int KIND> __device__ __forceinline__ void conv_mat(const float* W, const float* W2, int ldw, int K, bf16* WT, int nrows, LAS float* scr, int gw, int NGW, int lane) {
    const int nkb = K / 64, items = (nrows / 32) * nkb;
    for (int it = gw; it < items; it += NGW) {
        const int nb = it / nkb, kb = it % nkb, r0 = nb * 32; const float* src = W; int sc = r0, nv = 32;
        if (KIND == 1) { const int g = r0 >> 8, wi = r0 & 255; src = wi < 128 ? W : W2; sc = g * 128 + (wi & 127); }
        if (KIND == 2) { if (r0 < 3072) sc = r0; else if (r0 == 3072) { sc = 4096; nv = 8; } else { sc = 0; nv = 0; } }
        if (KIND == 3) sc = 4104 + r0;
        if (KIND == 4) sc = r0 < 1024 ? 3072 + r0 : 7432 + (r0 - 1024);
        tr_item(src, ldw, K, sc, nv, WT, r0, kb * 64, scr, lane);
    }
}
__device__ __forceinline__ void cvt_rows_bf16(const float* X, bf16* O, int gw, int NGW, int lane) {
    for (int m = gw; m < M; m += NGW) { const f32x4* xr = (const f32x4*)(X + (size_t)m * D) + lane; unsigned long long* o8 = (unsigned long long*)(O + (size_t)m * D) + lane;
#pragma unroll
        for (int j = 0; j < 4; ++j) { const f32x4 v = xr[64 * j]; o8[64 * j] = (unsigned long long)pk2(v.x, v.y) | ((unsigned long long)pk2(v.z, v.w) << 32); } }
}
__device__ __forceinline__ void ln_rows(const float* Y, const float* g, const float* b, float* outf, bf16* outb, int gw, int NGW, int lane) {
    f32x4 gv[4], bv[4];
#pragma unroll
    for (int j = 0; j < 4; ++j) { gv[j] = ((const f32x4*)g)[lane + 64 * j]; bv[j] = ((const f32x4*)b)[lane + 64 * j]; }
    for (int m = gw; m < M; m += NGW) {
        const f32x4* xr = (const f32x4*)(Y + (size_t)m * D) + lane;
        f32x4 v[4]; float s = 0.f;
#pragma unroll
        for (int j = 0; j < 4; ++j) { v[j] = xr[64 * j]; s += (v[j].x + v[j].y) + (v[j].z + v[j].w); }
        const float mean = wave_sum(s) * (1.f / D); float s2 = 0.f;
#pragma unroll
        for (int j = 0; j < 4; ++j) { v[j] = v[j] - mean; s2 += (v[j].x * v[j].x + v[j].y * v[j].y) + (v[j].z * v[j].z + v[j].w * v[j].w); }
        const float rstd = 1.f / sqrtf(wave_sum(s2) * (1.f / D) + 1e-5f);
        f32x4* of = (f32x4*)(outf + (size_t)m * D) + lane;
#pragma unroll
        for (int j = 0; j < 4; ++j) { v[j] = v[j] * rstd * gv[j] + bv[j]; of[64 * j] = v[j]; }
        if (outb) { unsigned long long* o8 = (unsigned long long*)(outb + (size_t)m * D) + lane;
#pragma unroll
            for (int j = 0; j < 4; ++j) o8[64 * j] = (unsigned long long)pk2(v[j].x, v[j].y) | ((unsigned long long)pk2(v[j].z, v[j].w) << 32); }
    }
}

__device__ __forceinline__ void conv8(const bf16* X, int row, int t, int col0, const float* cw, const float* cb, int cc0, float scale, float (&o)[8]) {
    float a[8];
#pragma unroll
    for (int j = 0; j < 8; ++j) a[j] = cb[cc0 + j];
#pragma unroll
    for (int tap = 0; tap < 4; ++tap) {
        const int dt = 3 - tap;
        if (t - dt >= 0) { float xv[8]; unpack8(*(const v4u*)(X + (size_t)(row - dt) * 1024 + col0), xv);
#pragma unroll
            for (int j = 0; j < 8; ++j) a[j] += xv[j] * cw[tap * 2048 + cc0 + j]; }
    }
#pragma unroll
    for (int j = 0; j < 8; ++j) o[j] = a[j] / (1.0f + __expf(-a[j])) * scale;
}
__device__ __forceinline__ void chunk_gates(const float* gates, int row0, int h, LAS float* tmp, LAS float* fbv, LAS float* iv, int tid) {
    if (tid < 128) { tmp[tid] = gates[(size_t)(row0 + tid) * 8 + 4 + h]; iv[tid] = gates[(size_t)(row0 + tid) * 8 + h]; }
    __syncthreads();
    if (tid < 128) { float s = 0.f; for (int j = 0; j <= tid; ++j) s += tmp[j]; fbv[tid] = s; }
    __syncthreads();
}
__device__ __forceinline__ void mlstm_passA(const Ptrs& P, LAS unsigned char* lds, int unit, int tid, int wave, int lane) {
    const bf16* MK = (const bf16*)(P.ws + WS_C); const bf16* MV = (const bf16*)(P.ws + WS_D); const float* gates = (const float*)(P.ws + WS_GATES);
    bf16* CB = (bf16*)(P.ws + WS_E) + (size_t)unit * 65536; float* NL = (float*)(P.ws + WS_NLOC) + unit * 256; float* GC = (float*)(P.ws + WS_GC);
    const int c = unit & 63, h = (unit >> 6) & 3, b = unit >> 8, row0 = b * T + c * 128;
    LAS bf16* VT = (LAS bf16*)lds; LAS bf16* KT = (LAS bf16*)(lds + 69632);
    LAS float* fbv = (LAS float*)(lds + 139264); LAS float* wa = fbv + 128; LAS float* tmp = wa + 128; LAS float* iv = tmp + 128;
    chunk_gates(gates, row0, h, tmp, fbv, iv, tid);
    const float G = fbv[127];
    if (tid < 128) wa[tid] = __expf(G - fbv[tid] + iv[tid]);
    __syncthreads();
    { const int s = tid & 127, g = tid >> 7; const float w_s = wa[s]; const int row = row0 + s, t = c * 128 + s;
#pragma unroll 2
      for (int i = 0; i < 8; ++i) { const int d0 = g * 64 + i * 8; float xv[8]; unpack8(*(const v4u*)(MV + (size_t)row * 1024 + h * 256 + d0), xv);
#pragma unroll
          for (int j = 0; j < 8; ++j) VT[(d0 + j) * 136 + s] = (bf16)f2bf(xv[j] * w_s);
          float kv[8]; conv8(MK, row, t, h * 256 + d0, P.cw, P.cb, 1024 + h * 256 + d0, 1.0f, kv);
#pragma unroll
          for (int j = 0; j < 8; ++j) KT[(d0 + j) * 136 + s] = (bf16)f2bf(kv[j]); } }
    __syncthreads();
    const int lr_ = lane & 31, lh = lane >> 5;
    if (tid < 256) { float s = 0.f; for (int j = 0; j < 128; ++j) s += bf1(KT[tid * 136 + j]) * wa[j]; NL[tid] = s; }
    if (tid == 0) GC[unit] = G;
    for (int hf = 0; hf < 2; ++hf) {
        f32x16 acc[4];
#pragma unroll
        for (int i = 0; i < 4; ++i)
#pragma unroll
            for (int j = 0; j < 16; ++j) acc[i][j] = 0.f;
#pragma unroll 2
        for (int ks = 0; ks < 8; ++ks) {
            const bf16x8 a = *(const LAS bf16x8*)(VT + (wave * 32 + lr_) * 136 + ks * 16 + 8 * lh);
#pragma unroll
            for (int nt = 0; nt < 4; ++nt) { const bf16x8 bb = *(const LAS bf16x8*)(KT + ((hf * 4 + nt) * 32 + lr_) * 136 + ks * 16 + 8 * lh); acc[nt] = MFMA32(a, bb, acc[nt]); }
        }
        bf16* cb0 = CB + (wave * 32 + 4 * lh) * 256 + hf * 128 + lr_;
#pragma unroll
        for (int nt = 0; nt < 4; ++nt)
#pragma unroll
            for (int r = 0; r < 16; ++r) cb0[((r & 3) + 8 * (r >> 2)) * 256 + nt * 32] = (bf16)f2bf(acc[nt][r]);
    }
    __syncthreads();
}
__device__ __forceinline__ void mlstm_passB(const Ptrs& P, int gtid, int gthreads) {
    bf16* CB = (bf16*)(P.ws + WS_E); float* NL = (float*)(P.ws + WS_NLOC); const float* GC = (const float*)(P.ws + WS_GC);
    for (int i = gtid; i < 8 * 16384; i += gthreads) {
        const int bh = i >> 14, e4 = i & 16383; float st[4] = {0.f, 0.f, 0.f, 0.f};
#pragma unroll 4
        for (int c = 0; c < 64; ++c) { unsigned long long* p = (unsigned long long*)(CB + ((size_t)(bh * 64 + c) * 65536 + e4 * 4)); const unsigned long long w = *p;
            const float dec = __expf(GC[bh * 64 + c]); const unsigned lo = (unsigned)w, hi = (unsigned)(w >> 32);
            *p = (unsigned long long)pk2(st[0], st[1]) | ((unsigned long long)pk2(st[2], st[3]) << 32);
            st[0] = st[0] * dec + bfl(lo); st[1] = st[1] * dec + bfh(lo); st[2] = st[2] * dec + bfl(hi); st[3] = st[3] * dec + bfh(hi); }
    }
    for (int i = gtid; i < 8 * 256; i += gthreads) { const int bh = i >> 8, d = i & 255; float st = 0.f;
        for (int c = 0; c < 64; ++c) { float* p = NL + (bh * 64 + c) * 256 + d; const float v = *p; *p = st; st = st * __expf(GC[bh * 64 + c]) + v; } }
}
__device__ __forceinline__ void mlstm_passC(const Ptrs& P, LAS unsigned char* lds, int unit, int tid, int wave, int lane) {
    asm volatile("" : "+v"(tid), "+v"(lane));
    const bf16* MQ = (const bf16*)(P.ws + WS_B); const bf16* MK = (const bf16*)(P.ws + WS_C); bf16* MV = (bf16*)(P.ws + WS_D); const float* gates = (const float*)(P.ws + WS_GATES);
    const bf16* CT = (const bf16*)(P.ws + WS_E) + (size_t)unit * 65536; const float* NP = (const float*)(P.ws + WS_NLOC) + unit * 256;
    const int c = unit & 63, h = (unit >> 6) & 3, b = unit >> 8, row0 = b * T + c * 128;
    LAS bf16* Q = (LAS bf16*)lds; LAS bf16* K = (LAS bf16*)(lds + 67584); LAS bf16* SS = K; LAS bf16* VT = (LAS bf16*)(lds + 67584 + 34816);
    LAS float* fbv = (LAS float*)(lds + 137216); LAS float* es = fbv + 128; LAS float* tmp = es + 128; LAS float* iv = tmp + 128; LAS float* npv = iv + 128; LAS float* den = npv + 256;
    LAS float* Hs = (LAS float*)lds;
    chunk_gates(gates, row0, h, tmp, fbv, iv, tid);
    if (tid < 128) es[tid] = __expf(iv[tid] - fbv[tid]);
    if (tid < 256) npv[tid] = NP[tid];
    { const int s = tid & 127, g = tid >> 7; const int row = row0 + s, t = c * 128 + s;
#pragma unroll 2
      for (int i = 0; i < 8; ++i) { const int d0 = g * 64 + i * 8; float qv[8], kv[8];
          conv8(MQ, row, t, h * 256 + d0, P.cw, P.cb, h * 256 + d0, 0.0625f, qv); conv8(MK, row, t, h * 256 + d0, P.cw, P.cb, 1024 + h * 256 + d0, 1.0f, kv);
          v4u wq, wk; wq.x = pk2(qv[0], qv[1]); wq.y = pk2(qv[2], qv[3]); wq.z = pk2(qv[4], qv[5]); wq.w = pk2(qv[6], qv[7]);
          wk.x = pk2(kv[0], kv[1]); wk.y = pk2(kv[2], kv[3]); wk.z = pk2(kv[4], kv[5]); wk.w = pk2(kv[6], kv[7]);
          *(LAS v4u*)(Q + s * 264 + d0) = wq; *(LAS v4u*)(K + s * 264 + d0) = wk; } }
    __syncthreads();
    const int lr_ = lane & 31, lh = lane >> 5, rt = wave >> 1, wp = wave & 1;
    {
        f32x16 sacc[2];
#pragma unroll
        for (int i = 0; i < 2; ++i)
#pragma unroll
            for (int j = 0; j < 16; ++j) sacc[i][j] = 0.f;
#pragma unroll 4
        for (int ks = 0; ks < 16; ++ks) {
            const bf16x8 a = *(const LAS bf16x8*)(Q + (rt * 32 + lr_) * 264 + ks * 16 + 8 * lh);
#pragma unroll
            for (int j = 0; j < 2; ++j) { const bf16x8 bb = *(const LAS bf16x8*)(K + ((wp * 2 + j) * 32 + lr_) * 264 + ks * 16 + 8 * lh); sacc[j] = MFMA32(a, bb, sacc[j]); }
        }
        __syncthreads();
#pragma unroll
        for (int j = 0; j < 2; ++j) { const int s = (wp * 2 + j) * 32 + lr_; const float e = es[s];
#pragma unroll
            for (int r = 0; r < 16; ++r) { const int t = rt * 32 + (r & 3) + 8 * (r >> 2) + 4 * lh; SS[t * 136 + s] = (bf16)f2bf(s <= t ? sacc[j][r] * e : 0.f); } }
    }
    f32x16 acc[2][2];
#pragma unroll
    for (int i = 0; i < 2; ++i)
#pragma unroll
        for (int j = 0; j < 2; ++j)
#pragma unroll
            for (int r = 0; r < 16; ++r) acc[i][j][r] = 0.f;
#pragma unroll 2
    for (int ks = 0; ks < 16; ++ks) {
        const bf16x8 a = *(const LAS bf16x8*)(Q + (rt * 32 + lr_) * 264 + ks * 16 + 8 * lh);
#pragma unroll
        for (int hv = 0; hv < 2; ++hv)
#pragma unroll
            for (int j = 0; j < 2; ++j) { const int v = hv * 128 + (wp * 2 + j) * 32 + lr_; const bf16x8 bb = *(const bf16x8*)(CT + (size_t)v * 256 + ks * 16 + 8 * lh); acc[hv][j] = MFMA32(a, bb, acc[hv][j]); }
    }
    for (int hv = 0; hv < 2; ++hv) {
        { const int s = tid & 127, g = tid >> 7; const int row = row0 + s;
#pragma unroll
          for (int i = 0; i < 4; ++i) { const int d0 = g * 32 + i * 8; float xv[8]; unpack8(*(const v4u*)(MV + (size_t)row * 1024 + h * 256 + hv * 128 + d0), xv);
#pragma unroll
              for (int j = 0; j < 8; ++j) VT[(d0 + j) * 136 + s] = (bf16)f2bf(xv[j]); } }
        __syncthreads();
        if (hv == 0 && tid < 128) { float s1 = 0.f; for (int j = 0; j < 128; ++j) s1 += bf1(SS[tid * 136 + j]); float s2 = 0.f; for (int j = 0; j < 256; ++j) s2 += bf1(Q[tid * 264 + j]) * npv[j]; den[tid] = s1 + s2; }
#pragma unroll 2
        for (int ks = 0; ks < 8; ++ks) {
            const bf16x8 a = *(const LAS bf16x8*)(SS + (rt * 32 + lr_) * 136 + ks * 16 + 8 * lh);
#pragma unroll
            for (int j = 0; j < 2; ++j) { const bf16x8 bb = *(const LAS bf16x8*)(VT + ((wp * 2 + j) * 32 + lr_) * 136 + ks * 16 + 8 * lh);
                if (hv == 0) acc[0][j] = MFMA32(a, bb, acc[0][j]); else acc[1][j] = MFMA32(a, bb, acc[1][j]); }
        }
        __syncthreads();
    }
    { LAS float* hs0 = Hs + (rt * 32 + 4 * lh) * 260 + wp * 64 + lr_;
#pragma unroll
      for (int r = 0; r < 16; ++r) { const int t = rt * 32 + (r & 3) + 8 * (r >> 2) + 4 * lh; const float eb = __expf(fbv[t]); const float sc = eb / fmaxf(fabsf(eb * den[t]), 1.0f);
#pragma unroll
          for (int hv = 0; hv < 2; ++hv)
#pragma unroll
              for (int j = 0; j < 2; ++j) hs0[((r & 3) + 8 * (r >> 2)) * 260 + hv * 128 + j * 32] = acc[hv][j][r] * sc; } }
    __syncthreads();
    for (int i = 0; i < 16; ++i) { const int t = wave * 16 + i; float x[4]; float s = 0.f;
#pragma unroll
        for (int j = 0; j < 4; ++j) { x[j] = Hs[t * 260 + lane + 64 * j]; s += x[j]; }
        const float mean = wave_sum(s) * (1.f / 256.f); float s2 = 0.f;
#pragma unroll
        for (int j = 0; j < 4; ++j) { x[j] -= mean; s2 += x[j] * x[j]; }
        const float rstd = 1.f / sqrtf(wave_sum(s2) * (1.f / 256.f) + 1e-5f);
#pragma unroll
        for (int j = 0; j < 4; ++j) { const int v = lane + 64 * j; MV[(size_t)(row0 + t) * 1024 + h * 256 + v] = (bf16)f2bf(x[j] * rstd * P.mng[h * 256 + v]); } }
    __syncthreads();
}

__device__ __forceinline__ float dpp_xor1(float x) { return __builtin_bit_cast(float, __builtin_amdgcn_update_dpp(0, __builtin_bit_cast(int, x), 0xB1, 0xF, 0xF, true)); }
__device__ __forceinline__ float dpp_xor2(float x) { return __builtin_bit_cast(float, __builtin_amdgcn_update_dpp(0, __builtin_bit_cast(int, x), 0x4E, 0xF, 0xF, true)); }
__device__ __forceinline__ float dpp_hmir(float x) { return __builtin_bit_cast(float, __builtin_amdgcn_update_dpp(0, __builtin_bit_cast(int, x), 0x141, 0xF, 0xF, true)); }
__device__ __forceinline__ float red8(float x) { x += dpp_xor1(x); x += dpp_xor2(x); x += dpp_hmir(x); return x; }
__device__ __forceinline__ void shift8(const bf16* X, int ld, int row, int t, int col0, const float* mu, float (&o)[8]) {
    float xc[8]; unpack8(*(const v4u*)(X + (size_t)row * ld + col0), xc);
    float xp[8];
    if (t > 0) unpack8(*(const v4u*)(X + (size_t)(row - 1) * ld + col0), xp); else {
#pragma unroll
        for (int j = 0; j < 8; ++j) xp[j] = 0.f; }
#pragma unroll
    for (int j = 0; j < 8; ++j) o[j] = xc[j] + (xp[j] - xc[j]) * mu[j];
}
__device__ __forceinline__ float dpp_rmir(float x) { return __builtin_bit_cast(float, __builtin_amdgcn_update_dpp(0, __builtin_bit_cast(int, x), 0x140, 0xF, 0xF, true)); }
__device__ __forceinline__ float red16(float x) { x += dpp_xor1(x); x += dpp_xor2(x); x += dpp_hmir(x); x += dpp_rmir(x); return x; }
struct RawRows { v4u rc, rp, kc, kp, wc, wp, ac, ap, vc, vp; };
__device__ __forceinline__ void rw_load(RawRows& R, const bf16* RR, const bf16* RK, const bf16* RV, const bf16* LR, int row, int t, int hc, int c0, int vcol, bool dov) {
    const v4u z = {0u, 0u, 0u, 0u};
    R.rc = *(const v4u*)(RR + (size_t)row * 1024 + hc); R.kc = *(const v4u*)(RK + (size_t)row * 1024 + hc);
    R.wc = *(const v4u*)(LR + (size_t)row * 256 + c0); R.ac = *(const v4u*)(LR + (size_t)row * 256 + 64 + c0);
    if (t > 0) { R.rp = *(const v4u*)(RR + (size_t)(row - 1) * 1024 + hc); R.kp = *(const v4u*)(RK + (size_t)(row - 1) * 1024 + hc);
        R.wp = *(const v4u*)(LR + (size_t)(row - 1) * 256 + c0); R.ap = *(const v4u*)(LR + (size_t)(row - 1) * 256 + 64 + c0); }
    else { R.rp = z; R.kp = z; R.wp = z; R.ap = z; }
    if (dov) { R.vc = *(const v4u*)(RV + (size_t)row * 1024 + vcol); R.vp = t > 0 ? *(const v4u*)(RV + (size_t)(row - 1) * 1024 + vcol) : z; } else { R.vc = z; R.vp = z; }
}
__device__ __forceinline__ void lerp8(const v4u c, const v4u p, const float (&mu)[8], float (&o)[8]) {
    float xc[8], xp[8]; unpack8(c, xc); unpack8(p, xp);
#pragma unroll
    for (int j = 0; j < 8; ++j) o[j] = xc[j] + (xp[j] - xc[j]) * mu[j];
}
constexpr int RCH = 32, NRCH = T / RCH;
struct RwBuf { LAS float *Wd, *Aa, *Bb, *Kp, *RW, *Vv, *SC, *YB; };
__device__ __forceinline__ RwBuf rw_buf(LAS unsigned char* lds, int i) { LAS float* b = (LAS float*)(lds + i * 45056); RwBuf r; r.Wd = b; r.Aa = b + 2048; r.Bb = b + 4096; r.Kp = b + 6144; r.RW = b + 8192; r.Vv = b + 10240; r.SC = b + 10496; r.YB = b + 10560; return r; }
__device__ __forceinline__ void rwkv_unit(const Ptrs& P, LAS unsigned char* lds, int unit, int tid, int wave, int lane) {
    const bf16* RR = (const bf16*)(P.ws + WS_B); const bf16* RK = (const bf16*)(P.ws + WS_C); const bf16* RV = (const bf16*)(P.ws + WS_RV); const bf16* LR = (const bf16*)(P.ws + WS_LR);
    bf16* YR = (bf16*)(P.ws + WS_YR); float* CTB = (float*)(P.ws + WS_CT);
    const bf16* W2T = (const bf16*)(P.ws + WS_W2T); const bf16* A2T = (const bf16*)(P.ws + WS_A2T);
    const int rg = unit & 7, h = (unit >> 3) & 15, b = unit >> 7;
    LAS float* AL = (LAS float*)(lds + 2 * 45056);
    LAS bf16* TW = (LAS bf16*)(AL + 2048);
    LAS bf16* TA = TW + 32 * 72;
    const bool is_rec = wave < 2, is_prep = (wave & 2) != 0, is_flush = wave == 4;
    const int pw = ((wave >> 2) << 1) | (wave & 1);
    const int pt = pw * 64 + lane, tok = pt >> 3, part = pt & 7, c0 = part * 8, hc = h * 64 + c0, vcol = h * 64 + rg * 8;
    float kkc[8], kac[8], rrk[8], mur[8], muk[8], muw[8], mua[8], muv[8];
#pragma unroll
    for (int j = 0; j < 8; ++j) { kkc[j] = P.rkk[hc + j]; kac[j] = P.rka[hc + j]; rrk[j] = P.rrk[hc + j]; mur[j] = P.rmu[hc + j]; muk[j] = P.rmu[1024 + hc + j]; muw[j] = P.rmu[3072 + c0 + j]; mua[j] = P.rmu[3136 + c0 + j]; muv[j] = P.rmu[2048 + vcol + j]; }
    const int lr_ = lane & 31, lh = lane >> 5;
    const int mat = (pw >> 1) & 1, mct = pw & 1, mcc = mct * 32 + lr_;
    bf16x8 bfr[4];
    { const bf16* Bg = (mat ? A2T : W2T) + (size_t)(h * 64 + mcc) * 64;
#pragma unroll
      for (int ks = 0; ks < 4; ++ks) bfr[ks] = *(const bf16x8*)(Bg + ks * 16 + 8 * lh); }
    const float mbias = mat ? P.ra0[h * 64 + mcc] : P.rw0[h * 64 + mcc];
    const int rl = lane >> 4, q4 = (lane & 15) * 4, ro = (wave & 1) * 4 + rl;
    f32x4 S = {0.f, 0.f, 0.f, 0.f};
    RawRows R; float r8[8], k8[8];
    if (is_prep) rw_load(R, RR, RK, RV, LR, b * T + tok, tok, hc, c0, vcol, part == 0);
#define PREP1(cc) do { const RwBuf B_ = rw_buf(lds, (cc) & 1); const int t_ = (cc) * RCH + tok, row_ = b * T + t_; \
        lerp8(R.rc, R.rp, mur, r8); lerp8(R.kc, R.kp, muk, k8); \
        { float w8[8], a8[8]; lerp8(R.wc, R.wp, muw, w8); lerp8(R.ac, R.ap, mua, a8); \
          _Pragma("unroll") for (int j = 0; j < 8; ++j) { const float e2 = __expf(2.f * w8[j]); w8[j] = 1.f - 2.f / (e2 + 1.f); } \
          v4u pw, pa; pw.x = pk2(w8[0], w8[1]); pw.y = pk2(w8[2], w8[3]); pw.z = pk2(w8[4], w8[5]); pw.w = pk2(w8[6], w8[7]); \
          pa.x = pk2(a8[0], a8[1]); pa.y = pk2(a8[2], a8[3]); pa.z = pk2(a8[4], a8[5]); pa.w = pk2(a8[6], a8[7]); \
          *(LAS v4u*)(TW + tok * 72 + c0) = pw; *(LAS v4u*)(TA + tok * 72 + c0) = pa; } \
        if (part == 0) { float v8[8]; lerp8(R.vc, R.vp, muv, v8); _Pragma("unroll") for (int j = 0; j < 8; ++j) B_.Vv[tok * 8 + j] = v8[j]; } \
        if ((cc) + 1 < NRCH) rw_load(R, RR, RK, RV, LR, row_ + RCH, t_ + RCH, hc, c0, vcol, part == 0); } while (0)
#define PREP2(cc) do { const RwBuf B_ = rw_buf(lds, (cc) & 1); const LAS bf16* As = mat ? TA : TW; f32x16 acc; \
        _Pragma("unroll") for (int j = 0; j < 16; ++j) acc[j] = 0.f; \
        _Pragma("unroll") for (int ks = 0; ks < 4; ++ks) { const bf16x8 a = *(const LAS bf16x8*)(As + lr_ * 72 + ks * 16 + 8 * lh); acc = MFMA32(a, bfr[ks], acc); } \
        _Pragma("unroll") for (int r = 0; r < 16; ++r) { const int tk = (r & 3) + 8 * (r >> 2) + 4 * lh; const float z = mbias + acc[r]; \
            if (mat) AL[tk * 64 + mcc] = sigm(z); \
            else { const float sp = fmaxf(-z, 0.f) + __logf(1.f + __expf(-fabsf(z))); B_.Wd[tk * 64 + mcc] = __expf(-__expf(-sp - 0.5f)); } } } while (0)
#define PREP3(cc) do { const RwBuf B_ = rw_buf(lds, (cc) & 1); const int row_ = b * T + (cc) * RCH + tok; float ss = 0.f, kkv[8]; \
        _Pragma("unroll") for (int j = 0; j < 8; ++j) { kkv[j] = k8[j] * kkc[j]; ss += kkv[j] * kkv[j]; } \
        ss = red8(ss); const float inv = 1.0f / fmaxf(sqrtf(ss), 1e-12f); float br = 0.f, kr = 0.f, cs = 0.f; \
        const f32x4 al0 = *(const LAS f32x4*)(AL + tok * 64 + c0), al1 = *(const LAS f32x4*)(AL + tok * 64 + c0 + 4), wd0 = *(const LAS f32x4*)(B_.Wd + tok * 64 + c0), wd1 = *(const LAS f32x4*)(B_.Wd + tok * 64 + c0 + 4); \
        f32x4 oa[2], ob[2], ok[2], orw[2]; \
        _Pragma("unroll") for (int j = 0; j < 8; ++j) { const float al = j < 4 ? al0[j & 3] : al1[j & 3], w = j < 4 ? wd0[j & 3] : wd1[j & 3], kk = kkv[j] * inv, kp = k8[j] * (1.f + (al - 1.f) * kac[j]), bb = kk * al; \
            oa[j >> 2][j & 3] = -kk; ob[j >> 2][j & 3] = bb; ok[j >> 2][j & 3] = kp; orw[j >> 2][j & 3] = r8[j] * w; br += bb * r8[j]; kr += kp * r8[j]; cs += r8[j] * kp * rrk[j]; } \
        _Pragma("unroll") for (int i = 0; i < 2; ++i) { *(LAS f32x4*)(B_.Aa + tok * 64 + c0 + 4 * i) = oa[i]; *(LAS f32x4*)(B_.Bb + tok * 64 + c0 + 4 * i) = ob[i]; *(LAS f32x4*)(B_.Kp + tok * 64 + c0 + 4 * i) = ok[i]; *(LAS f32x4*)(B_.RW + tok * 64 + c0 + 4 * i) = orw[i]; } \
        br = red8(br); kr = red8(kr); cs = red8(cs); \
        if (part == 0) { B_.SC[tok * 2] = br; B_.SC[tok * 2 + 1] = kr; if (rg == 0) CTB[(size_t)row_ * 16 + h] = cs; } } while (0)
#define RECSEG(cc, lo, hi) do { const RwBuf B_ = rw_buf(lds, (cc) & 1); \
        f32x4 a = *(const LAS f32x4*)(B_.Aa + (lo) * 64 + q4), y = *(const LAS f32x4*)(B_.RW + (lo) * 64 + q4), w = *(const LAS f32x4*)(B_.Wd + (lo) * 64 + q4), bb = *(const LAS f32x4*)(B_.Bb + (lo) * 64 + q4), k = *(const LAS f32x4*)(B_.Kp + (lo) * 64 + q4); \
        float vv = B_.Vv[(lo) * 8 + ro], brr = B_.SC[(lo) * 2], krr = B_.SC[(lo) * 2 + 1]; \
        _Pragma("unroll 2") for (int tk = (lo); tk < (hi); ++tk) { const int tn = tk + 1 < (hi) ? tk + 1 : tk; \
            const f32x4 an = *(const LAS f32x4*)(B_.Aa + tn * 64 + q4), yn = *(const LAS f32x4*)(B_.RW + tn * 64 + q4), wn = *(const LAS f32x4*)(B_.Wd + tn * 64 + q4), bn = *(const LAS f32x4*)(B_.Bb + tn * 64 + q4), kn = *(const LAS f32x4*)(B_.Kp + tn * 64 + q4); \
            const float vn = B_.Vv[tn * 8 + ro], brn = B_.SC[tn * 2], krn = B_.SC[tn * 2 + 1]; \
            float psa = (S[0] * a[0] + S[1] * a[1]) + (S[2] * a[2] + S[3] * a[3]); float py = (S[0] * y[0] + S[1] * y[1]) + (S[2] * y[2] + S[3] * y[3]); \
            const f32x4 u = k * vv, sw = S * w; psa = red16(psa); py = red16(py); S = sw + (bb * psa + u); \
            B_.YB[tk * 8 + ro] = py + psa * brr + vv * krr; \
            a = an; y = yn; w = wn; bb = bn; k = kn; vv = vn; brr = brn; krr = krn; } } while (0)
    if (is_prep) PREP1(0);
    __syncthreads();
    if (is_prep) PREP2(0);
    __syncthreads();
    if (is_prep) PREP3(0);
    __syncthreads();
    if (is_rec) __builtin_amdgcn_s_setprio(3);
    for (int ch = 0; ch < NRCH; ++ch) {
        if (is_rec) RECSEG(ch, 0, 10);
        if (is_prep && ch + 1 < NRCH) PREP1(ch + 1);
        if (is_flush && ch > 0 && lane < 32) { const RwBuf B_ = rw_buf(lds, (ch - 1) & 1); const LAS float* yb = B_.YB + lane * 8;
            v4u o; o.x = pk2(yb[0], yb[1]); o.y = pk2(yb[2], yb[3]); o.z = pk2(yb[4], yb[5]); o.w = pk2(yb[6], yb[7]);
            *(v4u*)(YR + (size_t)(b * T + (ch - 1) * RCH + lane) * 1024 + vcol) = o; }
        __syncthreads();
        if (is_rec) RECSEG(ch, 10, 22);
        if (is_prep && ch + 1 < NRCH) PREP2(ch + 1);
        __syncthreads();
        if (is_rec) RECSEG(ch, 22, 32);
        if (is_prep && ch + 1 < NRCH) PREP3(ch + 1);
        __syncthreads();
    }
    if (is_flush && lane < 32) { const RwBuf B_ = rw_buf(lds, (NRCH - 1) & 1); const LAS float* yb = B_.YB + lane * 8;
        v4u o; o.x = pk2(yb[0], yb[1]); o.y = pk2(yb[2], yb[3]); o.z = pk2(yb[4], yb[5]); o.w = pk2(yb[6], yb[7]);
        *(v4u*)(YR + (size_t)(b * T + (NRCH - 1) * RCH + lane) * 1024 + vcol) = o; }
    __builtin_amdgcn_s_setprio(0);
    __syncthreads();
#undef PREP1
#undef PREP2
#undef PREP3
#undef RECSEG
}
__device__ __forceinline__ void rwkv_post(const Ptrs& P, LAS unsigned char* lds, int tile, int tid, int wave, int lane) {
    const bf16* RV = (const bf16*)(P.ws + WS_RV); const bf16* LR = (const bf16*)(P.ws + WS_LR); bf16* YR = (bf16*)(P.ws + WS_YR); const float* CTB = (const float*)(P.ws + WS_CT);
    const bf16* G2T = (const bf16*)(P.ws + WS_G2T);
    LAS bf16* SG = (LAS bf16*)lds;
    LAS float* ST = (LAS float*)(lds + 64 * 136 * 2);
    const int tok = tid >> 3, part = tid & 7, row = tile * 64 + tok, t = row & (T - 1);
#pragma unroll
    for (int i = 0; i < 2; ++i) { const int c0 = part * 16 + i * 8; float mu[8], g8[8];
#pragma unroll
        for (int j = 0; j < 8; ++j) mu[j] = P.rmu[3200 + c0 + j];
        shift8(LR, 256, row, t, 128 + c0, mu, g8);
        v4u pg; pg.x = pk2(sigm(g8[0]), sigm(g8[1])); pg.y = pk2(sigm(g8[2]), sigm(g8[3])); pg.z = pk2(sigm(g8[4]), sigm(g8[5])); pg.w = pk2(sigm(g8[6]), sigm(g8[7]));
        *(LAS v4u*)(SG + tok * 136 + c0) = pg; }
#pragma unroll
    for (int i = 0; i < 2; ++i) { const int hd = part * 2 + i; float s = 0.f, s2 = 0.f;
#pragma unroll
        for (int k = 0; k < 8; ++k) { float x8[8]; unpack8(*(const v4u*)(YR + (size_t)row * 1024 + hd * 64 + k * 8), x8);
#pragma unroll
            for (int j = 0; j < 8; ++j) { s += x8[j]; s2 += x8[j] * x8[j]; } }
        const float mean = s * (1.f / 64.f); const float var = fmaxf(s2 * (1.f / 64.f) - mean * mean, 0.f);
        ST[(tok * 16 + hd) * 2] = mean; ST[(tok * 16 + hd) * 2 + 1] = 1.f / sqrtf(var + 64e-5f); }
    __syncthreads();
    const int lr_ = lane & 31, lh = lane >> 5;
    for (int hf = 0; hf < 2; ++hf) {
        f32x16 acc[2][2];
#pragma unroll
        for (int i = 0; i < 2; ++i)
#pragma unroll
            for (int j = 0; j < 2; ++j)
#pragma unroll
                for (int r = 0; r < 16; ++r) acc[i][j][r] = 0.f;
        const int cbase = wave * 128 + hf * 64;
#pragma unroll 2
        for (int ks = 0; ks < 8; ++ks) {
            bf16x8 a[2];
#pragma unroll
            for (int i = 0; i < 2; ++i) a[i] = *(const LAS bf16x8*)(SG + (i * 32 + lr_) * 136 + ks * 16 + 8 * lh);
#pragma unroll
            for (int j = 0; j < 2; ++j) { const bf16x8 bb = *(const bf16x8*)(G2T + (size_t)(cbase + j * 32 + lr_) * 128 + ks * 16 + 8 * lh);
#pragma unroll
                for (int i = 0; i < 2; ++i) acc[i][j] = MFMA32(a[i], bb, acc[i][j]); }
        }
        LAS bf16* GL = (LAS bf16*)(lds + 32768) + wave * (64 * 72);
#pragma unroll
        for (int j = 0; j < 2; ++j)
#pragma unroll
            for (int i = 0; i < 2; ++i)
#pragma unroll
                for (int r = 0; r < 16; ++r) GL[(i * 32 + (r & 3) + 8 * (r >> 2) + 4 * lh) * 72 + j * 32 + lr_] = (bf16)f2bf(acc[i][j][r]);
        asm volatile("s_waitcnt lgkmcnt(0)" ::: "memory");
        const int c8 = (lane & 7) * 8, chn0 = cbase + c8, hd = chn0 >> 6;
        float gg[8], gb[8], muv[8];
#pragma unroll
        for (int j = 0; j < 8; ++j) { gg[j] = P.gng[chn0 + j]; gb[j] = P.gnb[chn0 + j]; muv[j] = P.rmu[2048 + chn0 + j]; }
#pragma unroll 1
        for (int p = 0; p < 8; ++p) { const int tk = p * 8 + (lane >> 3), rw_ = tile * 64 + tk, tt = rw_ & (T - 1);
            float y8[8], v8[8], g8[8]; unpack8(*(const v4u*)(YR + (size_t)rw_ * 1024 + chn0), y8); shift8(RV, 1024, rw_, tt, chn0, muv, v8); unpack8(*(const LAS v4u*)(GL + tk * 72 + c8), g8);
            const float mean = ST[(tk * 16 + hd) * 2], rstd = ST[(tk * 16 + hd) * 2 + 1], ctv = CTB[(size_t)rw_ * 16 + hd];
            float o[8];
#pragma unroll
            for (int j = 0; j < 8; ++j) o[j] = (((y8[j] - mean) * rstd * gg[j] + gb[j]) + ctv * v8[j]) * g8[j];
            v4u w; w.x = pk2(o[0], o[1]); w.y = pk2(o[2], o[3]); w.z = pk2(o[4], o[5]); w.w = pk2(o[6], o[7]);
            *(v4u*)(YR + (size_t)rw_ * 1024 + chn0) = w; }
        asm volatile("s_waitcnt lgkmcnt(0)" ::: "memory");
    }
    __syncthreads();
}

struct Args { Ptrs p; int ph_lo, ph_hi, coop, pad; };
constexpr int N_PHASES = 18;
__global__ void __launch_bounds__(NTHR, 2) mk_fwd(Args args) {
    extern __shared__ __attribute__((aligned(16))) unsigned char lds_raw[];
    LAS unsigned char* lds = (LAS unsigned char*)lds_raw;
    const Ptrs& P = args.p;
    const int tid = threadIdx.x, lane = tid & 63, wave = __builtin_amdgcn_readfirstlane(tid >> 6);
    const int G = gridDim.x, bx = blockIdx.x, gw = bx * NWAVES + wave, NGW = G * NWAVES;
    unsigned char* ws = P.ws;
    bf16* XB = (bf16*)(ws + WS_XB); bf16* HB = (bf16*)(ws + WS_H);
    bf16* BB = (bf16*)(ws + WS_B); bf16* CBf = (bf16*)(ws + WS_C); bf16* DB = (bf16*)(ws + WS_D);
    const int lo = args.ph_lo, hi = args.ph_hi;
#ifndef PH_MASK
#define PH_MASK 0x3FFFF
#endif
#define IN(k) ((((PH_MASK) >> (k)) & 1) && lo <= (k) && (k) < hi)
#ifndef REP_MASK
#define REP_MASK 0
#endif
#define REP(k) for (int rep_ = 0; rep_ < ((((REP_MASK) >> (k)) & 1) + 1); ++rep_)
#define SEAM(k) do { if (IN(k) && IN((k) + 1)) { cg::this_grid().sync(); } } while (0)
    LAS float* scr = (LAS float*)(lds + wave * 16384);

    if (IN(0)) REP(0) {
        conv_mat<1>(P.f1g, P.f1u, FF, D, (bf16*)(ws + WS_WF), 5632, scr, gw, NGW, lane);
        conv_mat<0>(P.f1d, nullptr, D, FF, (bf16*)(ws + WS_WFD), 1024, scr, gw, NGW, lane);
        conv_mat<2>(P.win, nullptr, WIN_LD, D, (bf16*)(ws + WS_WIN1), 3328, scr, gw, NGW, lane);
        conv_mat<3>(P.win, nullptr, WIN_LD, D, (bf16*)(ws + WS_WIN2), 3328, scr, gw, NGW, lane);
        conv_mat<4>(P.win, nullptr, WIN_LD, D, (bf16*)(ws + WS_WIN3), 3072, scr, gw, NGW, lane);
        conv_mat<0>(P.wa, nullptr, D, D, (bf16*)(ws + WS_WA), 1024, scr, gw, NGW, lane);
        conv_mat<0>(P.wb, nullptr, D, D, (bf16*)(ws + WS_WB), 1024, scr, gw, NGW, lane);
        conv_mat<0>(P.wo, nullptr, D, D, (bf16*)(ws + WS_WO), 1024, scr, gw, NGW, lane);
        conv_mat<0>(P.rw2, nullptr, D, 64, (bf16*)(ws + WS_W2T), 1024, scr, gw, NGW, lane);
        conv_mat<0>(P.ra2, nullptr, D, 64, (bf16*)(ws + WS_A2T), 1024, scr, gw, NGW, lane);
        conv_mat<0>(P.rg2, nullptr, D, 128, (bf16*)(ws + WS_G2T), 1024, scr, gw, NGW, lane);
        cvt_rows_bf16(P.x, XB, gw, NGW, lane);
    }
    SEAM(0);
    if (IN(1)) REP(1) { pg8::Gemm g{XB, (const bf16*)(ws + WS_WF), M, 5632, D}; pg8::StaticOrder S; S.init(M, 5632, G, bx); pg8::EpiSwiGLU E{HB, FF};
        pg8::gemm_phase<pg8::EpiSwiGLU, pg8::StaticOrder, true, true>(lds, g, S, E); }
    SEAM(1);
    if (IN(2)) { pg8::Gemm g{HB, (const bf16*)(ws + WS_WFD), M, D, FF}; pg8::StaticOrder S; S.init(M, D, G, bx); pg8::EpiResid E{P.x, P.out, D, ALPHA, 0.5f};
        pg8::gemm_phase<pg8::EpiResid, pg8::StaticOrder, true, true>(lds, g, S, E); }
    SEAM(2);
    if (IN(3)) {
        ln_rows(P.out, P.ln1g, P.ln1b, P.out, XB, gw, NGW, lane);
        conv_mat<1>(P.f2g, P.f2u, FF, D, (bf16*)(ws + WS_WF), 5632, scr, gw, NGW, lane);
        conv_mat<0>(P.f2d, nullptr, D, FF, (bf16*)(ws + WS_WFD), 1024, scr, gw, NGW, lane);
    }
    SEAM(3);
    if (IN(4)) REP(4) { pg8::Gemm g{XB, (const bf16*)(ws + WS_WIN1), M, 3328, D}; pg8::StaticOrder S; S.init(M, 3328, G, bx);
        typedef pg8::EpiSplit<0, (long)(WS_C - WS_B) / 2, (long)(WS_D - WS_B) / 2> EP; EP E{BB, nullptr, (float*)(ws + WS_GATES), P.ib, P.fb};
        pg8::gemm_phase<EP, pg8::StaticOrder, true, true>(lds, g, S, E); }
    SEAM(4);
    if (IN(5)) REP(5) { for (int u = bx; u < 512; u += G) mlstm_passA(P, lds, u, tid, wave, lane); }
    SEAM(5);
    if (IN(6)) { mlstm_passB(P, bx * NTHR + tid, G * NTHR); }
    SEAM(6);
    if (IN(7)) { for (int u = bx; u < 512; u += G) mlstm_passC(P, lds, u, tid, wave, lane); }
    SEAM(7);
    if (IN(8)) REP(8) { pg8::Gemm g{XB, (const bf16*)(ws + WS_WIN2), M, 3328, D}; pg8::StaticOrder S; S.init(M, 3328, G, bx);
        typedef pg8::EpiSplit<1, (long)(WS_C - WS_B) / 2, (long)(WS_RV - WS_B) / 2> EP; EP E{BB, (bf16*)(ws + WS_LR), nullptr, nullptr, nullptr};
        pg8::gemm_phase<EP, pg8::StaticOrder, true, true>(lds, g, S, E); }
    SEAM(8);
    if (IN(9)) REP(9) { for (int u = bx; u < 256; u += G) rwkv_unit(P, lds, u, tid, wave, lane); }
    SEAM(9);
    if (IN(10)) { for (int u = bx; u < M / 64; u += G) rwkv_post(P, lds, u, tid, wave, lane); }
    SEAM(10);
    if (IN(11)) { pg8::Gemm g{XB, (const bf16*)(ws + WS_WIN3), M, 3072, D}; pg8::StaticOrder S; S.init(M, 3072, G, bx);
        typedef pg8::EpiSplit<2, -(long)(WS_D - WS_C) / 2, -(long)(WS_D - WS_B) / 2> EP; EP E{DB, nullptr, nullptr, nullptr, nullptr};
        pg8::gemm_phase<EP, pg8::StaticOrder, true, true>(lds, g, S, E); }
    SEAM(11);
    if (IN(12)) {
        { pg8::Gemm g{DB, (const bf16*)(ws + WS_WA), M, D, D}; pg8::StaticOrder S; S.init(M, D, G, bx); pg8::EpiBranch<false> E{CBf, nullptr};
          pg8::gemm_phase<pg8::EpiBranch<false>, pg8::StaticOrder, true, true>(lds, g, S, E); }
        __syncthreads();
        { pg8::Gemm g{(const bf16*)(ws + WS_YR), (const bf16*)(ws + WS_WB), M, D, D}; pg8::StaticOrder S; S.init(M, D, G, bx); pg8::EpiBranch<true> E{BB, CBf};
          pg8::gemm_phase<pg8::EpiBranch<true>, pg8::StaticOrder, true, true>(lds, g, S, E); }
    }
    SEAM(12);
    if (IN(13)) { pg8::Gemm g{BB, (const bf16*)(ws + WS_WO), M, D, D}; pg8::StaticOrder S; S.init(M, D, G, bx); pg8::EpiResid E{P.out, P.out, D, ALPHA, 1.0f};
        pg8::gemm_phase<pg8::EpiResid, pg8::StaticOrder, true, true>(lds, g, S, E); }
    SEAM(13);
    if (IN(14)) { ln_rows(P.out, P.ln2g, P.ln2b, P.out, XB, gw, NGW, lane); }
    SEAM(14);
    if (IN(15)) { pg8::Gemm g{XB, (const bf16*)(ws + WS_WF), M, 5632, D}; pg8::StaticOrder S; S.init(M, 5632, G, bx); pg8::EpiSwiGLU E{HB, FF};
        pg8::gemm_phase<pg8::EpiSwiGLU, pg8::StaticOrder, true, true>(lds, g, S, E); }
    SEAM(15);
    if (IN(16)) { pg8::Gemm g{HB, (const bf16*)(ws + WS_WFD), M, D, FF}; pg8::StaticOrder S; S.init(M, D, G, bx); pg8::EpiResid E{P.out, P.out, D, ALPHA, 0.5f};
        pg8::gemm_phase<pg8::EpiResid, pg8::StaticOrder, true, true>(lds, g, S, E); }
    SEAM(16);
    if (IN(17)) { ln_rows(P.out, P.ln3g, P.ln3b, P.out, nullptr, gw, NGW, lane); }
#undef IN
#undef SEAM
}

#ifndef MK_N_LAUNCHES
#define MK_N_LAUNCHES 1
#endif
extern "C" void kernel_launch(void* const* d_in, const int* in_sizes, int n_in, void* d_out, int out_size, void* d_ws, size_t ws_size, hipStream_t stream) {
    static int grid = 0;
    if (grid == 0) {
        int dev = 0, cus = 0, per_cu = 0;
        hipGetDevice(&dev); hipDeviceGetAttribute(&cus, hipDeviceAttributeMultiprocessorCount, dev);
        hipFuncSetAttribute((const void*)mk_fwd, hipFuncAttributeMaxDynamicSharedMemorySize, LDS_BYTES);
        hipOccupancyMaxActiveBlocksPerMultiprocessor(&per_cu, (const void*)mk_fwd, NTHR, LDS_BYTES);
        if (per_cu < 1) { fprintf(stderr, "kernel_launch: occupancy query reports %d blocks per CU\n", per_cu); per_cu = 1; }
        grid = cus;
        if (n_in != 33 || ws_size < WS_END) fprintf(stderr, "kernel_launch: unexpected n_in %d / ws_size %zu\n", n_in, ws_size);
        (void)hipGetLastError();
    }
    Args a{};
    const float** pp = (const float**)&a.p;
    for (int i = 0; i < 33; ++i) pp[i] = (const float*)d_in[i];
    a.p.out = (float*)d_out; a.p.ws = (unsigned char*)d_ws;
    if (MK_N_LAUNCHES == 1) {
        a.ph_lo = 0; a.ph_hi = N_PHASES; a.coop = 1;
        void* kargs[] = {&a};
        hipError_t e = hipLaunchCooperativeKernel((const void*)mk_fwd, dim3(grid), dim3(NTHR), kargs, LDS_BYTES, stream);
        if (e != hipSuccess) fprintf(stderr, "cooperative launch failed: %s (grid %d)\n", hipGetErrorString(e), grid);
    } else {
        for (int ph = 0; ph < N_PHASES; ++ph) { a.ph_lo = ph; a.ph_hi = ph + 1; a.coop = 0; hipLaunchKernelGGL(mk_fwd, dim3(grid), dim3(NTHR), LDS_BYTES, stream, a); }
    }
}
```

```cpp
#include <hip/hip_runtime.h>
#include <hip/hip_cooperative_groups.h>
#include <cstdio>
#include <cstdint>
namespace cg = cooperative_groups;
namespace pg8 {
#define PG8_LAS __attribute__((address_space(3)))
typedef unsigned short bf16_t;
typedef short bf16x8 __attribute__((ext_vector_type(8)));
typedef float f32x4 __attribute__((ext_vector_type(4)));
typedef unsigned u32x4 __attribute__((ext_vector_type(4)));
constexpr int BM = 256, BK = 64, HALF = 128, HTB = HALF * BK * 2  , STAGE_BYTES = 8 * HTB, NXCD = 8, WGM = 8;

__host__ __device__ __forceinline__ int lds_byte(int r, int c) { const int st = (r >> 4) * 2 + (c >> 5), rr = r & 15, cc = c & 31, ob = rr * 64 + cc * 2; return st * 1024 + (ob ^ (((ob >> 9) & 1) << 5)); }
__host__ __device__ __forceinline__ void stage_rc(int b, int& R, int& C) { const int st = b / 1024, sb = b % 1024, swz = sb ^ (((sb >> 9) & 1) << 5); R = (st >> 1) * 16 + swz / 64; C = (st & 1) * 32 + (swz % 64) / 2; }
__host__ __device__ __forceinline__ int perm32(int rho) { const int n = rho >> 4, i = rho & 15; return 8 * (i >> 2) + 4 * n + (i & 3); }

struct Unit { int pm, pn; };
struct Gemm { const bf16_t* A; const bf16_t* Bt; int M, N, K; };

struct StaticOrder {
    int nM, nN, nwg, G, c;
    __host__ __device__ void init(int M, int N, int G_, int c_) { nM = M / BM; nN = N / BM; nwg = nM * nN; G = G_; c = c_; }
    __host__ __device__ bool next(int i, Unit& u) const {
        const long L = (long)i * G + c; if (L >= nwg) return false;
        int wgid = (int)L; { const int q = nwg / NXCD, r = nwg % NXCD, xcd = wgid % NXCD, off = wgid / NXCD; wgid = (xcd < r ? xcd * (q + 1) : r * (q + 1) + (xcd - r) * q) + off; }
        const int nig = WGM * nN, gid = wgid / nig, fm = gid * WGM, gsz = (nM - fm) < WGM ? (nM - fm) : WGM;
        u.pm = fm + ((wgid % nig) % gsz); u.pn = (wgid % nig) / gsz; return true;
    }
    __device__ __forceinline__ void a_ready(const Unit&) const {}
    __device__ __forceinline__ void done(const Unit&) const {}
};

__device__ __forceinline__ unsigned cvt_pk_bf16(float lo, float hi) { unsigned r; asm volatile("v_cvt_pk_bf16_f32 %0, %1, %2" : "=v"(r) : "v"(lo), "v"(hi)); return r; }
__device__ __forceinline__ float bf_lo(unsigned w) { return __uint_as_float(w << 16); }
__device__ __forceinline__ float bf_hi(unsigned w) { return __uint_as_float(w & 0xffff0000u); }
__device__ __forceinline__ float sigmoidf_(float x) { return 1.0f / (1.0f + __expf(-x)); }
__device__ __forceinline__ float siluf_(float x) { return x / (1.0f + __expf(-x)); }

struct EpiSwiGLU {
    static constexpr bool PERM = true, AFTER_DRAIN = false;
    bf16_t* H; int ldh;
    __device__ __forceinline__ void operator()(const f32x4 (&acc)[2][2][4][2], const Unit& u, int wr, int wc, int fr, int fq) const {
        const int row0 = u.pm * BM + wr * 64 + fr, col0 = u.pn * 128 + wc * 32 + 8 * fq;
#pragma unroll
        for (int ai = 0; ai < 2; ++ai)
#pragma unroll
            for (int m = 0; m < 4; ++m) {
                bf16_t* rowp = H + (size_t)(row0 + ai * HALF + m * 16) * ldh + col0;
                const f32x4 g0 = acc[ai][0][m][0], g1 = acc[ai][0][m][1], u0 = acc[ai][1][m][0], u1 = acc[ai][1][m][1];
                u32x4 w;
                w.x = cvt_pk_bf16(siluf_(g0[0]) * u0[0], siluf_(g0[1]) * u0[1]); w.y = cvt_pk_bf16(siluf_(g0[2]) * u0[2], siluf_(g0[3]) * u0[3]);
                w.z = cvt_pk_bf16(siluf_(g1[0]) * u1[0], siluf_(g1[1]) * u1[1]); w.w = cvt_pk_bf16(siluf_(g1[2]) * u1[2], siluf_(g1[3]) * u1[3]);
                *(u32x4*)rowp = w;
            }
    }
};
struct EpiResid {
    static constexpr bool PERM = false, AFTER_DRAIN = false;
    const float* res; float* out; int ldc; float alpha, scale;
    __device__ __forceinline__ void operator()(const f32x4 (&acc)[2][2][4][2], const Unit& u, int wr, int wc, int fr, int fq) const {
        const int row0 = u.pm * BM + wr * 64 + fr, col0 = u.pn * BM + wc * 32 + 4 * fq;
#pragma unroll
        for (int ai = 0; ai < 2; ++ai)
#pragma unroll
            for (int m = 0; m < 4; ++m) {
                const size_t off = (size_t)(row0 + ai * HALF + m * 16) * ldc + col0;
#pragma unroll
                for (int bj = 0; bj < 2; ++bj)
#pragma unroll
                    for (int n = 0; n < 2; ++n) {
                        const f32x4 r = *(const f32x4*)(res + off + bj * HALF + n * 16);
                        *(f32x4*)(out + off + bj * HALF + n * 16) = r * alpha + acc[ai][bj][m][n] * scale;
                    }
            }
    }
};
template <int MODE, long OFF1, long OFF2> struct EpiSplit {
    static constexpr bool PERM = true, AFTER_DRAIN = false;
    bf16_t* buf0; bf16_t* buf3; float* gates; const float* ib; const float* fb;
    __device__ __forceinline__ void operator()(const f32x4 (&acc)[2][2][4][2], const Unit& u, int wr, int wc, int fr, int fq) const {
        const int grp = u.pn >> 2, row0 = u.pm * BM + wr * 64 + fr;
        if (grp == 3) {
            if (MODE == 0) {
                if (wc == 0 && fq == 0) {
                    const f32x4 bi = *(const f32x4*)ib, bf = *(const f32x4*)fb;
#pragma unroll
                    for (int ai = 0; ai < 2; ++ai)
#pragma unroll
                        for (int m = 0; m < 4; ++m) {
                            float* g = gates + (size_t)(row0 + ai * HALF + m * 16) * 8;
                            const f32x4 vi = acc[ai][0][m][0] + bi; f32x4 vf = acc[ai][0][m][1] + bf;
#pragma unroll
                            for (int j = 0; j < 4; ++j) { const float x = vf[j]; vf[j] = fminf(x, 0.f) - log1pf(__expf(-fabsf(x))); }
                            *(f32x4*)g = vi; *(f32x4*)(g + 4) = vf;
                        }
                }
            } else if (MODE == 1) {
                const int col0 = wc * 32 + 8 * fq;
#pragma unroll
                for (int ai = 0; ai < 2; ++ai)
#pragma unroll
                    for (int m = 0; m < 4; ++m) { bf16_t* rowp = buf3 + (size_t)(row0 + ai * HALF + m * 16) * 256 + col0;
#pragma unroll
                        for (int bj = 0; bj < 2; ++bj) { const f32x4 v0 = acc[ai][bj][m][0], v1 = acc[ai][bj][m][1]; u32x4 w;
                            w.x = cvt_pk_bf16(v0[0], v0[1]); w.y = cvt_pk_bf16(v0[2], v0[3]); w.z = cvt_pk_bf16(v1[0], v1[1]); w.w = cvt_pk_bf16(v1[2], v1[3]);
                            *(u32x4*)(rowp + bj * HALF) = w; } }
            }
            return;
        }
        bf16_t* base = buf0 + (grp == 0 ? 0L : (grp == 1 ? OFF1 : OFF2));
        const int col0 = (u.pn & 3) * BM + wc * 32 + 8 * fq;
#pragma unroll
        for (int ai = 0; ai < 2; ++ai)
#pragma unroll
            for (int m = 0; m < 4; ++m) { bf16_t* rowp = base + (size_t)(row0 + ai * HALF + m * 16) * 1024 + col0;
#pragma unroll
                for (int bj = 0; bj < 2; ++bj) { f32x4 v0 = acc[ai][bj][m][0], v1 = acc[ai][bj][m][1];
                    if (MODE == 2) {
#pragma unroll
                        for (int j = 0; j < 4; ++j) { v0[j] = sigmoidf_(v0[j]); v1[j] = sigmoidf_(v1[j]); }
                        if (grp == 0) { const u32x4 o = *(const u32x4*)(rowp + bj * HALF);
                            v0[0] *= bf_lo(o.x); v0[1] *= bf_hi(o.x); v0[2] *= bf_lo(o.y); v0[3] *= bf_hi(o.y);
                            v1[0] *= bf_lo(o.z); v1[1] *= bf_hi(o.z); v1[2] *= bf_lo(o.w); v1[3] *= bf_hi(o.w); }
                    }
                    u32x4 w; w.x = cvt_pk_bf16(v0[0], v0[1]); w.y = cvt_pk_bf16(v0[2], v0[3]); w.z = cvt_pk_bf16(v1[0], v1[1]); w.w = cvt_pk_bf16(v1[2], v1[3]);
                    *(u32x4*)(rowp + bj * HALF) = w; } }
    }
};
template <bool SECOND> struct EpiBranch {
    static constexpr bool PERM = true, AFTER_DRAIN = false;
    bf16_t* G; const bf16_t* T1;
    __device__ __forceinline__ void operator()(const f32x4 (&acc)[2][2][4][2], const Unit& u, int wr, int wc, int fr, int fq) const {
        const int row0 = u.pm * BM + wr * 64 + fr, col0 = u.pn * BM + wc * 32 + 8 * fq;
#pragma unroll
        for (int ai = 0; ai < 2; ++ai)
#pragma unroll
            for (int m = 0; m < 4; ++m) { const size_t off = (size_t)(row0 + ai * HALF + m * 16) * 1024 + col0;
#pragma unroll
                for (int bj = 0; bj < 2; ++bj) { const f32x4 a0 = acc[ai][bj][m][0], a1 = acc[ai][bj][m][1];
                    const u32x4 g = *(const u32x4*)(G + off + bj * HALF);
                    float r[8] = { bf_lo(g.x) * a0[0], bf_hi(g.x) * a0[1], bf_lo(g.y) * a0[2], bf_hi(g.y) * a0[3], bf_lo(g.z) * a1[0], bf_hi(g.z) * a1[1], bf_lo(g.w) * a1[2], bf_hi(g.w) * a1[3] };
                    if (SECOND) { const u32x4 t = *(const u32x4*)(T1 + off + bj * HALF);
                        r[0] += bf_lo(t.x); r[1] += bf_hi(t.x); r[2] += bf_lo(t.y); r[3] += bf_hi(t.y); r[4] += bf_lo(t.z); r[5] += bf_hi(t.z); r[6] += bf_lo(t.w); r[7] += bf_hi(t.w); }
                    u32x4 w; w.x = cvt_pk_bf16(r[0], r[1]); w.y = cvt_pk_bf16(r[2], r[3]); w.z = cvt_pk_bf16(r[4], r[5]); w.w = cvt_pk_bf16(r[6], r[7]);
                    *(u32x4*)(G + off + bj * HALF) = w; } }
    }
};

template <class Epi, class Sched, bool ALIGN_EPI = false, bool SP2 = false>
__device__ __forceinline__ void gemm_phase(PG8_LAS unsigned char* lds, const Gemm g, const Sched& S, const Epi& E) {
    const int tid = threadIdx.x, wid = __builtin_amdgcn_readfirstlane(tid >> 6), lane = tid & 63, wr = wid >> 2, wc = wid & 3, fr = lane & 15, fq = lane >> 4;
    const int K = g.K, nt = K / BK;
    unsigned voffA[2], voffB[2];
#pragma unroll
    for (int i = 0; i < 2; ++i) { int R, C; stage_rc(tid * 16 + i * 8192, R, C); const int Rb = Epi::PERM ? ((R & ~31) + perm32(R & 31)) : R;
        voffA[i] = (unsigned)(R * K + C) * 2u; voffB[i] = (unsigned)(Rb * K + C) * 2u; }
    const size_t kstep = (size_t)(BK * 2);
    const size_t hstep = (size_t)HALF * K * 2;
    const size_t tstep = 2 * hstep;
    const unsigned ldsw = (unsigned)wid * 1024u;
    const int aoff = lds_byte(wr * 64 + fr, fq * 8), boff = lds_byte(wc * 32 + fr, fq * 8);
#define PG8_SA(b, h) (((b) * 2 + (h)) * HTB)
#define PG8_SB(b, h) ((4 + (b) * 2 + (h)) * HTB)
#define PG8_STAGE(bufoff, gbase, voff) do { _Pragma("unroll") for (int _i = 0; _i < 2; ++_i) \
        __builtin_amdgcn_global_load_lds((const unsigned*)((const char*)(gbase) + (voff)[_i]), (PG8_LAS unsigned*)(lds + (bufoff) + ldsw + _i * 8192), 16, 0, 0); } while (0)
#define PG8_LDA(dst, b, h) do { _Pragma("unroll") for (int m = 0; m < 4; ++m) _Pragma("unroll") for (int k = 0; k < 2; ++k) dst[m][k] = *(const PG8_LAS bf16x8*)(lds + PG8_SA(b, h) + aoff + m * 2048 + k * 1024); } while (0)
#define PG8_LDB(dst, b, h) do { _Pragma("unroll") for (int n = 0; n < 2; ++n) _Pragma("unroll") for (int k = 0; k < 2; ++k) dst[n][k] = *(const PG8_LAS bf16x8*)(lds + PG8_SB(b, h) + boff + n * 2048 + k * 1024); } while (0)
#define PG8_MMA(ai, bj, At, Bt) do { __builtin_amdgcn_s_setprio(1); _Pragma("unroll") for (int m = 0; m < 4; ++m) _Pragma("unroll") for (int n = 0; n < 2; ++n) _Pragma("unroll") for (int k = 0; k < 2; ++k) \
        acc[ai][bj][m][n] = __builtin_amdgcn_mfma_f32_16x16x32_bf16(Bt[n][k], At[m][k], acc[ai][bj][m][n], 0, 0, 0); __builtin_amdgcn_s_setprio(0); } while (0)
#define PG8_WAIT_V(n) asm volatile("s_waitcnt vmcnt(" #n ")" ::: "memory")
#define PG8_WAIT_L(n) asm volatile("s_waitcnt lgkmcnt(" #n ")" ::: "memory")
#define PG8_BAR __builtin_amdgcn_s_barrier()
#define PG8_SCHED __builtin_amdgcn_sched_barrier(0)
    Unit cur, nxt; int ui = 0;
    if (!S.next(0, cur)) return;
    f32x4 acc[2][2][4][2];
#pragma unroll
    for (int a = 0; a < 2; ++a)
#pragma unroll
        for (int b = 0; b < 2; ++b)
#pragma unroll
            for (int m = 0; m < 4; ++m)
#pragma unroll
                for (int n = 0; n < 2; ++n) acc[a][b][m][n] = (f32x4){0.f, 0.f, 0.f, 0.f};
    bf16x8 At[4][2], B0[2][2], B1[2][2];
    const char* cA = (const char*)g.A + (size_t)cur.pm * tstep; const char* cB = (const char*)g.Bt + (size_t)cur.pn * tstep;
    S.a_ready(cur);
    if constexpr (SP2) {
        PG8_STAGE(PG8_SB(0, 0), cB, voffB); PG8_STAGE(PG8_SB(0, 1), cB + hstep, voffB); PG8_STAGE(PG8_SA(0, 0), cA, voffA); PG8_STAGE(PG8_SA(0, 1), cA + hstep, voffA);
        if (wr == 1) PG8_BAR;
        PG8_WAIT_V(2); PG8_BAR;
        PG8_STAGE(PG8_SB(1, 0), cB + kstep, voffB); PG8_STAGE(PG8_SA(1, 0), cA + kstep, voffA); PG8_STAGE(PG8_SB(1, 1), cB + hstep + kstep, voffB);
        PG8_WAIT_V(6); PG8_BAR;
    } else {
        PG8_STAGE(PG8_SB(0, 0), cB, voffB); PG8_STAGE(PG8_SA(0, 0), cA, voffA); PG8_STAGE(PG8_SB(0, 1), cB + hstep, voffB); PG8_STAGE(PG8_SA(0, 1), cA + hstep, voffA);
        if (wr == 1) PG8_BAR;
        PG8_WAIT_V(4); PG8_BAR;
        PG8_STAGE(PG8_SB(1, 0), cB + kstep, voffB); PG8_STAGE(PG8_SA(1, 0), cA + kstep, voffA); PG8_STAGE(PG8_SB(1, 1), cB + hstep + kstep, voffB);
        PG8_WAIT_V(6); PG8_BAR;
    }
    for (;;) {
        const bool has_next = S.next(ui + 1, nxt);
        const char* nA = has_next ? (const char*)g.A + (size_t)nxt.pm * tstep : cA; const char* nB = has_next ? (const char*)g.Bt + (size_t)nxt.pn * tstep : cB;
        for (int t = 0; t < nt; t += 2) {
            const bool last = (t == nt - 2);
            const char* a1 = cA + (size_t)(t + 1) * kstep;
            const char* a2 = last ? nA : cA + (size_t)(t + 2) * kstep; const char* b2 = last ? nB : cB + (size_t)(t + 2) * kstep;
            const char* a3 = a2 + kstep; const char* b3 = b2 + kstep;
            if (last && has_next) S.a_ready(nxt);
            if constexpr (SP2) {
            PG8_LDB(B0, 0, 0); PG8_LDB(B1, 0, 1); PG8_SCHED; PG8_LDA(At, 0, 0); PG8_STAGE(PG8_SA(1, 1), a1 + hstep, voffA);
            PG8_WAIT_V(8); PG8_WAIT_L(0); PG8_BAR; PG8_MMA(0, 0, At, B0); PG8_MMA(0, 1, At, B1); PG8_BAR; PG8_SCHED;
            PG8_LDA(At, 0, 1); PG8_STAGE(PG8_SB(0, 0), b2, voffB); PG8_STAGE(PG8_SB(0, 1), b2 + hstep, voffB); PG8_STAGE(PG8_SA(0, 0), a2, voffA);
            PG8_WAIT_V(8); PG8_WAIT_L(0); PG8_BAR; PG8_MMA(1, 0, At, B0); PG8_MMA(1, 1, At, B1); PG8_BAR; PG8_SCHED;
            PG8_LDB(B0, 1, 0); PG8_LDB(B1, 1, 1); PG8_SCHED; PG8_LDA(At, 1, 0); PG8_STAGE(PG8_SA(0, 1), a2 + hstep, voffA);
            PG8_WAIT_V(8); PG8_WAIT_L(0); PG8_BAR; PG8_MMA(0, 0, At, B0); PG8_MMA(0, 1, At, B1); PG8_BAR; PG8_SCHED;
            PG8_LDA(At, 1, 1); PG8_STAGE(PG8_SB(1, 0), b3, voffB); PG8_STAGE(PG8_SB(1, 1), b3 + hstep, voffB); PG8_STAGE(PG8_SA(1, 0), a3, voffA);
            PG8_WAIT_V(8); PG8_WAIT_L(0); PG8_BAR; PG8_MMA(1, 0, At, B0); PG8_MMA(1, 1, At, B1); PG8_BAR; PG8_SCHED;
            } else {
            PG8_LDB(B0, 0, 0); PG8_SCHED; PG8_LDA(At, 0, 0); PG8_STAGE(PG8_SA(1, 1), a1 + hstep, voffA);
            PG8_WAIT_L(8); PG8_BAR; PG8_WAIT_L(0); PG8_MMA(0, 0, At, B0); PG8_BAR; PG8_SCHED;
            PG8_LDB(B1, 0, 1); PG8_STAGE(PG8_SB(0, 0), b2, voffB);
            PG8_BAR; PG8_WAIT_L(0); PG8_MMA(0, 1, At, B1); PG8_BAR;
            PG8_LDA(At, 0, 1); PG8_STAGE(PG8_SA(0, 0), a2, voffA);
            PG8_BAR; PG8_WAIT_L(0); PG8_MMA(1, 0, At, B0); PG8_BAR; PG8_SCHED;
            PG8_STAGE(PG8_SB(0, 1), b2 + hstep, voffB);
            PG8_WAIT_V(6); PG8_BAR; PG8_MMA(1, 1, At, B1); PG8_BAR;
            PG8_LDB(B0, 1, 0); PG8_SCHED; PG8_LDA(At, 1, 0); PG8_STAGE(PG8_SA(0, 1), a2 + hstep, voffA);
            PG8_WAIT_L(8); PG8_BAR; PG8_WAIT_L(0); PG8_MMA(0, 0, At, B0); PG8_BAR; PG8_SCHED;
            PG8_LDB(B1, 1, 1); PG8_STAGE(PG8_SB(1, 0), b3, voffB);
            PG8_BAR; PG8_WAIT_L(0); PG8_MMA(0, 1, At, B1); PG8_BAR;
            PG8_LDA(At, 1, 1); PG8_STAGE(PG8_SA(1, 0), a3, voffA);
            PG8_BAR; PG8_WAIT_L(0); PG8_MMA(1, 0, At, B0); PG8_BAR; PG8_SCHED;
            PG8_STAGE(PG8_SB(1, 1), b3 + hstep, voffB);
            PG8_WAIT_V(6); PG8_BAR; PG8_MMA(1, 1, At, B1); PG8_BAR;
            }
        }
        if constexpr (ALIGN_EPI) { if (wr == 0) PG8_BAR; }
        if constexpr (!Epi::AFTER_DRAIN) { E(acc, cur, wr, wc, fr, fq); S.done(cur); }
        if (!has_next) break;
#pragma unroll
        for (int a = 0; a < 2; ++a)
#pragma unroll
            for (int b = 0; b < 2; ++b)
#pragma unroll
                for (int m = 0; m < 4; ++m)
#pragma unroll
                    for (int n = 0; n < 2; ++n) acc[a][b][m][n] = (f32x4){0.f, 0.f, 0.f, 0.f};
        cur = nxt; cA = nA; cB = nB; ++ui;
        if constexpr (ALIGN_EPI) { if (wr == 1) PG8_BAR; }
    }
    PG8_WAIT_V(0);
    if constexpr (!ALIGN_EPI) { if (wr == 0) PG8_BAR; }
    PG8_BAR;
    if constexpr (Epi::AFTER_DRAIN) { E.fused(acc, cur, wr, wc, fr, fq, lds, wid, lane); S.done(cur); }
#undef PG8_SA
#undef PG8_SB
#undef PG8_STAGE
#undef PG8_LDA
#undef PG8_LDB
#undef PG8_MMA
#undef PG8_WAIT_V
#undef PG8_WAIT_L
#undef PG8_BAR
#undef PG8_SCHED
}
}

constexpr int NWAVES = 8, NTHR = 512;
constexpr int BATCH = 2, T = 8192, D = 1024, FF = 2816, M = BATCH * T;
constexpr int WIN_LD = 9480;
constexpr float ALPHA = 1.189207115002721f;
constexpr size_t MiB = 1u << 20;
constexpr size_t WS_GATES = 1 * MiB;
constexpr size_t WS_CT = WS_GATES + 512 * 1024;
constexpr size_t WS_NLOC = WS_CT + 1 * MiB;
constexpr size_t WS_GC = WS_NLOC + 512 * 1024;
constexpr size_t WS_W2T = WS_GC + 64 * 1024;
constexpr size_t WS_A2T = WS_W2T + 128 * 1024;
constexpr size_t WS_G2T = WS_A2T + 128 * 1024;
constexpr size_t WS_WIN1 = 4 * MiB;
constexpr size_t WS_WIN2 = WS_WIN1 + 6656 * 1024;
constexpr size_t WS_WIN3 = WS_WIN2 + 6656 * 1024;
constexpr size_t WS_WA = 23 * MiB, WS_WB = 25 * MiB, WS_WO = 27 * MiB;
constexpr size_t WS_WF = 29 * MiB;
constexpr size_t WS_WFD = 40 * MiB;
constexpr size_t WS_XB = 46 * MiB;
constexpr size_t WS_B = 78 * MiB, WS_C = 110 * MiB, WS_D = 142 * MiB, WS_E = 174 * MiB;
constexpr size_t WS_H = WS_B;
constexpr size_t WS_RV = WS_E, WS_LR = WS_E + 32 * MiB, WS_YR = WS_E + 40 * MiB;
constexpr size_t WS_END = WS_YR + 32 * MiB;
static_assert(WS_G2T + 256 * 1024 <= WS_WIN1 && WS_WIN3 + 6 * MiB <= WS_WA && WS_WFD + 5632 * 1024 <= WS_XB && WS_H + (size_t)M * FF * 2 <= WS_E && WS_END <= 256 * MiB, "ws map");
constexpr int LDS_BYTES = 147456;

#define LAS __attribute__((address_space(3)))
typedef unsigned short bf16;
typedef unsigned v4u __attribute__((ext_vector_type(4)));
typedef float f32x4 __attribute__((ext_vector_type(4)));
typedef float f32x16 __attribute__((ext_vector_type(16)));
typedef short bf16x8 __attribute__((ext_vector_type(8)));
__device__ __forceinline__ unsigned f2bf(float f) { unsigned u = __builtin_bit_cast(unsigned, f); return (u + 0x7fffu + ((u >> 16) & 1u)) >> 16; }
__device__ __forceinline__ unsigned pk2(float lo, float hi) { return pg8::cvt_pk_bf16(lo, hi); }
__device__ __forceinline__ float bfl(unsigned w) { return __uint_as_float(w << 16); }
__device__ __forceinline__ float bfh(unsigned w) { return __uint_as_float(w & 0xffff0000u); }
__device__ __forceinline__ float bf1(bf16 h) { return __uint_as_float((unsigned)h << 16); }
__device__ __forceinline__ void unpack8(const v4u w, float (&o)[8]) { o[0] = bfl(w.x); o[1] = bfh(w.x); o[2] = bfl(w.y); o[3] = bfh(w.y); o[4] = bfl(w.z); o[5] = bfh(w.z); o[6] = bfl(w.w); o[7] = bfh(w.w); }
__device__ __forceinline__ float sigm(float x) { return 1.0f / (1.0f + __expf(-x)); }
__device__ __forceinline__ float wave_sum(float v) {
#pragma unroll
    for (int o = 1; o < 64; o <<= 1) v += __shfl_xor(v, o);
    return v;
}
#define MFMA32(a, b, c) __builtin_amdgcn_mfma_f32_32x32x16_bf16(a, b, c, 0, 0, 0)

struct Ptrs {
    const float* x; const float *f1g, *f1u, *f1d, *ln1g, *ln1b, *win, *cw, *cb, *ib, *fb, *mng, *rmu, *rw0, *rw2, *ra0, *ra2, *rg2, *rkk, *rka, *rrk, *gng, *gnb, *wa, *wb, *wo, *ln2g, *ln2b, *f2g, *f2u, *f2d, *ln3g, *ln3b;
    float* out; unsigned char* ws;
};

__device__ __forceinline__ void tr_item(const float* W, int ldw, int K, int src_col0, int nvalid, bf16* WT, int dst_row0, int k0, LAS float* scr, int lane) {
    const int n_ = lane & 31;
#pragma unroll 8
    for (int i = 0; i < 32; ++i) { const int kk = 2 * i + (lane >> 5); scr[kk * 33 + n_] = (n_ < nvalid) ? W[(size_t)(k0 + kk) * ldw + src_col0 + n_] : 0.f; }
    asm volatile("s_waitcnt lgkmcnt(0)" ::: "memory");
    const int c = lane & 7;
#pragma unroll
    for (int j = 0; j < 4; ++j) { const int n = (lane >> 3) + 8 * j; const LAS float* s = scr + (8 * c) * 33 + n;
        v4u o; o.x = pk2(s[0 * 33], s[1 * 33]); o.y = pk2(s[2 * 33], s[3 * 33]); o.z = pk2(s[4 * 33], s[5 * 33]); o.w = pk2(s[6 * 33], s[7 * 33]);
        *(v4u*)(WT + (size_t)(dst_row0 + n) * K + k0 + 8 * c) = o; }
    asm volatile("s_waitcnt lgkmcnt(0)" ::: "memory");
}
template <int KIND> __device__ __forceinline__ void conv_mat(const float* W, const float* W2, int ldw, int K, bf16* WT, int nrows, LAS float* scr, int gw, int NGW, int lane) {
    const int nkb = K / 64, items = (nrows / 32) * nkb;
    for (int it = gw; it < items; it += NGW) {
        const int nb = it / nkb, kb = it % nkb, r0 = nb * 32; const float* src = W; int sc = r0, nv = 32;
        if (KIND == 1) { const int g = r0 >> 8, wi = r0 & 255; src = wi < 128 ? W : W2; sc = g * 128 + (wi & 127); }
        if (KIND == 2) { if (r0 < 3072) sc = r0; else if (r0 == 3072) { sc = 4096; nv = 8; } else { sc = 0; nv = 0; } }
        if (KIND == 3) sc = 4104 + r0;
        if (KIND == 4) sc = r0 < 1024 ? 3072 + r0 : 7432 + (r0 - 1024);
        tr_item(src, ldw, K, sc, nv, WT, r0, kb * 64, scr, lane);
    }
}
__device__ __forceinline__ void cvt_rows_bf16(const float* X, bf16* O, int gw, int NGW, int lane) {
    for (int m = gw; m < M; m += NGW) { const f32x4* xr = (const f32x4*)(X + (size_t)m * D) + lane; unsigned long long* o8 = (unsigned long long*)(O + (size_t)m * D) + lane;
#pragma unroll
        for (int j = 0; j < 4; ++j) { const f32x4 v = xr[64 * j]; o8[64 * j] = (unsigned long long)pk2(v.x, v.y) | ((unsigned long long)pk2(v.z, v.w) << 32); } }
}
__device__ __forceinline__ void ln_rows(const float* Y, const float* g, const float* b, float* outf, bf16* outb, int gw, int NGW, int lane) {
    f32x4 gv[4], bv[4];
#pragma unroll
    for (int j = 0; j < 4; ++j) { gv[j] = ((const f32x4*)g)[lane + 64 * j]; bv[j] = ((const f32x4*)b)[lane + 64 * j]; }
    for (int m = gw; m < M; m += NGW) {
        const f32x4* xr = (const f32x4*)(Y + (size_t)m * D) + lane;
        f32x4 v[4]; float s = 0.f;
#pragma unroll
        for (int j = 0; j < 4; ++j) { v[j] = xr[64 * j]; s += (v[j].x + v[j].y) + (v[j].z + v[j].w); }
        const float mean = wave_sum(s) * (1.f / D); float s2 = 0.f;
#pragma unroll
        for (int j = 0; j < 4; ++j) { v[j] = v[j] - mean; s2 += (v[j].x * v[j].x + v[j].y * v[j].y) + (v[j].z * v[j].z + v[j].w * v[j].w); }
        const float rstd = 1.f / sqrtf(wave_sum(s2) * (1.f / D) + 1e-5f);
        f32x4* of = (f32x4*)(outf + (size_t)m * D) + lane;
#pragma unroll
        for (int j = 0; j < 4; ++j) { v[j] = v[j] * rstd * gv[j] + bv[j]; of[64 * j] = v[j]; }
        if (outb) { unsigned long long* o8 = (unsigned long long*)(outb + (size_t)m * D) + lane;
#pragma unroll
            for (int j = 0; j < 4; ++j) o8[64 * j] = (unsigned long long)pk2(v[j].x, v[j].y) | ((unsigned long long)pk2(v[j].z, v[j].w) << 32); }
    }
}

__device__ __forceinline__ void conv8(const bf16* X, int row, int t, int col0, const float* cw, const float* cb, int cc0, float scale, float (&o)[8]) {
    float a[8];
#pragma unroll
    for (int j = 0; j < 8; ++j) a[j] = cb[cc0 + j];
#pragma unroll
    for (int tap = 0; tap < 4; ++tap) {
        const int dt = 3 - tap;
        if (t - dt >= 0) { float xv[8]; unpack8(*(const v4u*)(X + (size_t)(row - dt) * 1024 + col0), xv);
#pragma unroll
            for (int j = 0; j < 8; ++j) a[j] += xv[j] * cw[tap * 2048 + cc0 + j]; }
    }
#pragma unroll
    for (int j = 0; j < 8; ++j) o[j] = a[j] / (1.0f + __expf(-a[j])) * scale;
}
__device__ __forceinline__ void chunk_gates(const float* gates, int row0, int h, LAS float* tmp, LAS float* fbv, LAS float* iv, int tid) {
    if (tid < 128) { tmp[tid] = gates[(size_t)(row0 + tid) * 8 + 4 + h]; iv[tid] = gates[(size_t)(row0 + tid) * 8 + h]; }
    __syncthreads();
    if (tid < 128) { float s = 0.f; for (int j = 0; j <= tid; ++j) s += tmp[j]; fbv[tid] = s; }
    __syncthreads();
}
__device__ __forceinline__ void mlstm_passA(const Ptrs& P, LAS unsigned char* lds, int unit, int tid, int wave, int lane) {
    const bf16* MK = (const bf16*)(P.ws + WS_C); const bf16* MV = (const bf16*)(P.ws + WS_D); const float* gates = (const float*)(P.ws + WS_GATES);
    bf16* CB = (bf16*)(P.ws + WS_E) + (size_t)unit * 65536; float* NL = (float*)(P.ws + WS_NLOC) + unit * 256; float* GC = (float*)(P.ws + WS_GC);
    const int c = unit & 63, h = (unit >> 6) & 3, b = unit >> 8, row0 = b * T + c * 128;
    LAS bf16* VT = (LAS bf16*)lds; LAS bf16* KT = (LAS bf16*)(lds + 69632);
    LAS float* fbv = (LAS float*)(lds + 139264); LAS float* wa = fbv + 128; LAS float* tmp = wa + 128; LAS float* iv = tmp + 128;
    chunk_gates(gates, row0, h, tmp, fbv, iv, tid);
    const float G = fbv[127];
    if (tid < 128) wa[tid] = __expf(G - fbv[tid] + iv[tid]);
    __syncthreads();
    { const int s = tid & 127, g = tid >> 7; const float w_s = wa[s]; const int row = row0 + s, t = c * 128 + s;
#pragma unroll 2
      for (int i = 0; i < 8; ++i) { const int d0 = g * 64 + i * 8; float xv[8]; unpack8(*(const v4u*)(MV + (size_t)row * 1024 + h * 256 + d0), xv);
#pragma unroll
          for (int j = 0; j < 8; ++j) VT[(d0 + j) * 136 + s] = (bf16)f2bf(xv[j] * w_s);
          float kv[8]; conv8(MK, row, t, h * 256 + d0, P.cw, P.cb, 1024 + h * 256 + d0, 1.0f, kv);
#pragma unroll
          for (int j = 0; j < 8; ++j) KT[(d0 + j) * 136 + s] = (bf16)f2bf(kv[j]); } }
    __syncthreads();
    const int lr_ = lane & 31, lh = lane >> 5;
    if (tid < 256) { float s = 0.f; for (int j = 0; j < 128; ++j) s += bf1(KT[tid * 136 + j]) * wa[j]; NL[tid] = s; }
    if (tid == 0) GC[unit] = G;
    for (int hf = 0; hf < 2; ++hf) {
        f32x16 acc[4];
#pragma unroll
        for (int i = 0; i < 4; ++i)
#pragma unroll
            for (int j = 0; j < 16; ++j) acc[i][j] = 0.f;
#pragma unroll 2
        for (int ks = 0; ks < 8; ++ks) {
            const bf16x8 a = *(const LAS bf16x8*)(VT + (wave * 32 + lr_) * 136 + ks * 16 + 8 * lh);
#pragma unroll
            for (int nt = 0; nt < 4; ++nt) { const bf16x8 bb = *(const LAS bf16x8*)(KT + ((hf * 4 + nt) * 32 + lr_) * 136 + ks * 16 + 8 * lh); acc[nt] = MFMA32(a, bb, acc[nt]); }
        }
        bf16* cb0 = CB + (wave * 32 + 4 * lh) * 256 + hf * 128 + lr_;
#pragma unroll
        for (int nt = 0; nt < 4; ++nt)
#pragma unroll
            for (int r = 0; r < 16; ++r) cb0[((r & 3) + 8 * (r >> 2)) * 256 + nt * 32] = (bf16)f2bf(acc[nt][r]);
    }
    __syncthreads();
}
__device__ __forceinline__ void mlstm_passB(const Ptrs& P, int gtid, int gthreads) {
    bf16* CB = (bf16*)(P.ws + WS_E); float* NL = (float*)(P.ws + WS_NLOC); const float* GC = (const float*)(P.ws + WS_GC);
    for (int i = gtid; i < 8 * 16384; i += gthreads) {
        const int bh = i >> 14, e4 = i & 16383; float st[4] = {0.f, 0.f, 0.f, 0.f};
#pragma unroll 4
        for (int c = 0; c < 64; ++c) { unsigned long long* p = (unsigned long long*)(CB + ((size_t)(bh * 64 + c) * 65536 + e4 * 4)); const unsigned long long w = *p;
            const float dec = __expf(GC[bh * 64 + c]); const unsigned lo = (unsigned)w, hi = (unsigned)(w >> 32);
            *p = (unsigned long long)pk2(st[0], st[1]) | ((unsigned long long)pk2(st[2], st[3]) << 32);
            st[0] = st[0] * dec + bfl(lo); st[1] = st[1] * dec + bfh(lo); st[2] = st[2] * dec + bfl(hi); st[3] = st[3] * dec + bfh(hi); }
    }
    for (int i = gtid; i < 8 * 256; i += gthreads) { const int bh = i >> 8, d = i & 255; float st = 0.f;
        for (int c = 0; c < 64; ++c) { float* p = NL + (bh * 64 + c) * 256 + d; const float v = *p; *p = st; st = st * __expf(GC[bh * 64 + c]) + v; } }
}
__device__ __forceinline__ void mlstm_passC(const Ptrs& P, LAS unsigned char* lds, int unit, int tid, int wave, int lane) {
    asm volatile("" : "+v"(tid), "+v"(lane));
    const bf16* MQ = (const bf16*)(P.ws + WS_B); const bf16* MK = (const bf16*)(P.ws + WS_C); bf16* MV = (bf16*)(P.ws + WS_D); const float* gates = (const float*)(P.ws + WS_GATES);
    const bf16* CT = (const bf16*)(P.ws + WS_E) + (size_t)unit * 65536; const float* NP = (const float*)(P.ws + WS_NLOC) + unit * 256;
    const int c = unit & 63, h = (unit >> 6) & 3, b = unit >> 8, row0 = b * T + c * 128;
    LAS bf16* Q = (LAS bf16*)lds; LAS bf16* K = (LAS bf16*)(lds + 67584); LAS bf16* SS = K; LAS bf16* VT = (LAS bf16*)(lds + 67584 + 34816);
    LAS float* fbv = (LAS float*)(lds + 137216); LAS float* es = fbv + 128; LAS float* tmp = es + 128; LAS float* iv = tmp + 128; LAS float* npv = iv + 128; LAS float* den = npv + 256;
    LAS float* Hs = (LAS float*)lds;
    chunk_gates(gates, row0, h, tmp, fbv, iv, tid);
    if (tid < 128) es[tid] = __expf(iv[tid] - fbv[tid]);
    if (tid < 256) npv[tid] = NP[tid];
    { const int s = tid & 127, g = tid >> 7; const int row = row0 + s, t = c * 128 + s;
#pragma unroll 2
      for (int i = 0; i < 8; ++i) { const int d0 = g * 64 + i * 8; float qv[8], kv[8];
          conv8(MQ, row, t, h * 256 + d0, P.cw, P.cb, h * 256 + d0, 0.0625f, qv); conv8(MK, row, t, h * 256 + d0, P.cw, P.cb, 1024 + h * 256 + d0, 1.0f, kv);
          v4u wq, wk; wq.x = pk2(qv[0], qv[1]); wq.y = pk2(qv[2], qv[3]); wq.z = pk2(qv[4], qv[5]); wq.w = pk2(qv[6], qv[7]);
          wk.x = pk2(kv[0], kv[1]); wk.y = pk2(kv[2], kv[3]); wk.z = pk2(kv[4], kv[5]); wk.w = pk2(kv[6], kv[7]);
          *(LAS v4u*)(Q + s * 264 + d0) = wq; *(LAS v4u*)(K + s * 264 + d0) = wk; } }
    __syncthreads();
    const int lr_ = lane & 31, lh = lane >> 5, rt = wave >> 1, wp = wave & 1;
    {
        f32x16 sacc[2];
#pragma unroll
        for (int i = 0; i < 2; ++i)
#pragma unroll
            for (int j = 0; j < 16; ++j) sacc[i][j] = 0.f;
#pragma unroll 4
        for (int ks = 0; ks < 16; ++ks) {
            const bf16x8 a = *(const LAS bf16x8*)(Q + (rt * 32 + lr_) * 264 + ks * 16 + 8 * lh);
#pragma unroll
            for (int j = 0; j < 2; ++j) { const bf16x8 bb = *(const LAS bf16x8*)(K + ((wp * 2 + j) * 32 + lr_) * 264 + ks * 16 + 8 * lh); sacc[j] = MFMA32(a, bb, sacc[j]); }
        }
        __syncthreads();
#pragma unroll
        for (int j = 0; j < 2; ++j) { const int s = (wp * 2 + j) * 32 + lr_; const float e = es[s];
#pragma unroll
            for (int r = 0; r < 16; ++r) { const int t = rt * 32 + (r & 3) + 8 * (r >> 2) + 4 * lh; SS[t * 136 + s] = (bf16)f2bf(s <= t ? sacc[j][r] * e : 0.f); } }
    }
    f32x16 acc[2][2];
#pragma unroll
    for (int i = 0; i < 2; ++i)
#pragma unroll
        for (int j = 0; j < 2; ++j)
#pragma unroll
            for (int r = 0; r < 16; ++r) acc[i][j][r] = 0.f;
#pragma unroll 2
    for (int ks = 0; ks < 16; ++ks) {
        const bf16x8 a = *(const LAS bf16x8*)(Q + (rt * 32 + lr_) * 264 + ks * 16 + 8 * lh);
#pragma unroll
        for (int hv = 0; hv < 2; ++hv)
#pragma unroll
            for (int j = 0; j < 2; ++j) { const int v = hv * 128 + (wp * 2 + j) * 32 + lr_; const bf16x8 bb = *(const bf16x8*)(CT + (size_t)v * 256 + ks * 16 + 8 * lh); acc[hv][j] = MFMA32(a, bb, acc[hv][j]); }
    }
    for (int hv = 0; hv < 2; ++hv) {
        { const int s = tid & 127, g = tid >> 7; const int row = row0 + s;
#pragma unroll
          for (int i = 0; i < 4; ++i) { const int d0 = g * 32 + i * 8; float xv[8]; unpack8(*(const v4u*)(MV + (size_t)row * 1024 + h * 256 + hv * 128 + d0), xv);
#pragma unroll
              for (int j = 0; j < 8; ++j) VT[(d0 + j) * 136 + s] = (bf16)f2bf(xv[j]); } }
        __syncthreads();
        if (hv == 0 && tid < 128) { float s1 = 0.f; for (int j = 0; j < 128; ++j) s1 += bf1(SS[tid * 136 + j]); float s2 = 0.f; for (int j = 0; j < 256; ++j) s2 += bf1(Q[tid * 264 + j]) * npv[j]; den[tid] = s1 + s2; }
#pragma unroll 2
        for (int ks = 0; ks < 8; ++ks) {
            const bf16x8 a = *(const LAS bf16x8*)(SS + (rt * 32 + lr_) * 136 + ks * 16 + 8 * lh);
#pragma unroll
            for (int j = 0; j < 2; ++j) { const bf16x8 bb = *(const LAS bf16x8*)(VT + ((wp * 2 + j) * 32 + lr_) * 136 + ks * 16 + 8 * lh);
                if (hv == 0) acc[0][j] = MFMA32(a, bb, acc[0][j]); else acc[1][j] = MFMA32(a, bb, acc[1][j]); }
        }
        __syncthreads();
    }
    { LAS float* hs0 = Hs + (rt * 32 + 4 * lh) * 260 + wp * 64 + lr_;
#pragma unroll
      for (int r = 0; r < 16; ++r) { const int t = rt * 32 + (r & 3) + 8 * (r >> 2) + 4 * lh; const float eb = __expf(fbv[t]); const float sc = eb / fmaxf(fabsf(eb * den[t]), 1.0f);
#pragma unroll
          for (int hv = 0; hv < 2; ++hv)
#pragma unroll
              for (int j = 0; j < 2; ++j) hs0[((r & 3) + 8 * (r >> 2)) * 260 + hv * 128 + j * 32] = acc[hv][j][r] * sc; } }
    __syncthreads();
    for (int i = 0; i < 16; ++i) { const int t = wave * 16 + i; float x[4]; float s = 0.f;
#pragma unroll
        for (int j = 0; j < 4; ++j) { x[j] = Hs[t * 260 + lane + 64 * j]; s += x[j]; }
        const float mean = wave_sum(s) * (1.f / 256.f); float s2 = 0.f;
#pragma unroll
        for (int j = 0; j < 4; ++j) { x[j] -= mean; s2 += x[j] * x[j]; }
        const float rstd = 1.f / sqrtf(wave_sum(s2) * (1.f / 256.f) + 1e-5f);
#pragma unroll
        for (int j = 0; j < 4; ++j) { const int v = lane + 64 * j; MV[(size_t)(row0 + t) * 1024 + h * 256 + v] = (bf16)f2bf(x[j] * rstd * P.mng[h * 256 + v]); } }
    __syncthreads();
}

__device__ __forceinline__ float dpp_xor1(float x) { return __builtin_bit_cast(float, __builtin_amdgcn_update_dpp(0, __builtin_bit_cast(int, x), 0xB1, 0xF, 0xF, true)); }
__device__ __forceinline__ float dpp_xor2(float x) { return __builtin_bit_cast(float, __builtin_amdgcn_update_dpp(0, __builtin_bit_cast(int, x), 0x4E, 0xF, 0xF, true)); }
__device__ __forceinline__ float dpp_hmir(float x) { return __builtin_bit_cast(float, __builtin_amdgcn_update_dpp(0, __builtin_bit_cast(int, x), 0x141, 0xF, 0xF, true)); }
__device__ __forceinline__ float red8(float x) { x += dpp_xor1(x); x += dpp_xor2(x); x += dpp_hmir(x); return x; }
__device__ __forceinline__ void shift8(const bf16* X, int ld, int row, int t, int col0, const float* mu, float (&o)[8]) {
    float xc[8]; unpack8(*(const v4u*)(X + (size_t)row * ld + col0), xc);
    float xp[8];
    if (t > 0) unpack8(*(const v4u*)(X + (size_t)(row - 1) * ld + col0), xp); else {
#pragma unroll
        for (int j = 0; j < 8; ++j) xp[j] = 0.f; }
#pragma unroll
    for (int j = 0; j < 8; ++j) o[j] = xc[j] + (xp[j] - xc[j]) * mu[j];
}
__device__ __forceinline__ float dpp_rmir(float x) { return __builtin_bit_cast(float, __builtin_amdgcn_update_dpp(0, __builtin_bit_cast(int, x), 0x140, 0xF, 0xF, true)); }
__device__ __forceinline__ float red16(float x) { x += dpp_xor1(x); x += dpp_xor2(x); x += dpp_hmir(x); x += dpp_rmir(x); return x; }
struct RawRows { v4u rc, rp, kc, kp, wc, wp, ac, ap, vc, vp; };
__device__ __forceinline__ void rw_load(RawRows& R, const bf16* RR, const bf16* RK, const bf16* RV, const bf16* LR, int row, int t, int hc, int c0, int vcol, bool dov) {
    const v4u z = {0u, 0u, 0u, 0u};
    R.rc = *(const v4u*)(RR + (size_t)row * 1024 + hc); R.kc = *(const v4u*)(RK + (size_t)row * 1024 + hc);
    R.wc = *(const v4u*)(LR + (size_t)row * 256 + c0); R.ac = *(const v4u*)(LR + (size_t)row * 256 + 64 + c0);
    if (t > 0) { R.rp = *(const v4u*)(RR + (size_t)(row - 1) * 1024 + hc); R.kp = *(const v4u*)(RK + (size_t)(row - 1) * 1024 + hc);
        R.wp = *(const v4u*)(LR + (size_t)(row - 1) * 256 + c0); R.ap = *(const v4u*)(LR + (size_t)(row - 1) * 256 + 64 + c0); }
    else { R.rp = z; R.kp = z; R.wp = z; R.ap = z; }
    if (dov) { R.vc = *(const v4u*)(RV + (size_t)row * 1024 + vcol); R.vp = t > 0 ? *(const v4u*)(RV + (size_t)(row - 1) * 1024 + vcol) : z; } else { R.vc = z; R.vp = z; }
}
__device__ __forceinline__ void lerp8(const v4u c, const v4u p, const float (&mu)[8], float (&o)[8]) {
    float xc[8], xp[8]; unpack8(c, xc); unpack8(p, xp);
#pragma unroll
    for (int j = 0; j < 8; ++j) o[j] = xc[j] + (xp[j] - xc[j]) * mu[j];
}
constexpr int RCH = 32, NRCH = T / RCH;
struct RwBuf { LAS float *Wd, *Aa, *Bb, *Kp, *RW, *Vv, *SC, *YB; };
__device__ __forceinline__ RwBuf rw_buf(LAS unsigned char* lds, int i) { LAS float* b = (LAS float*)(lds + i * 45056); RwBuf r; r.Wd = b; r.Aa = b + 2048; r.Bb = b + 4096; r.Kp = b + 6144; r.RW = b + 8192; r.Vv = b + 10240; r.SC = b + 10496; r.YB = b + 10560; return r; }
__device__ __forceinline__ void rwkv_unit(const Ptrs& P, LAS unsigned char* lds, int unit, int tid, int wave, int lane) {
    const bf16* RR = (const bf16*)(P.ws + WS_B); const bf16* RK = (const bf16*)(P.ws + WS_C); const bf16* RV = (const bf16*)(P.ws + WS_RV); const bf16* LR = (const bf16*)(P.ws + WS_LR);
    bf16* YR = (bf16*)(P.ws + WS_YR); float* CTB = (float*)(P.ws + WS_CT);
    const bf16* W2T = (const bf16*)(P.ws + WS_W2T); const bf16* A2T = (const bf16*)(P.ws + WS_A2T);
    const int rg = unit & 7, h = (unit >> 3) & 15, b = unit >> 7;
    LAS float* AL = (LAS float*)(lds + 2 * 45056);
    LAS bf16* TW = (LAS bf16*)(AL + 2048);
    LAS bf16* TA = TW + 32 * 72;
    const bool is_rec = wave < 2, is_prep = wave >= 2 && wave < 6, is_flush = wave == 6;
    const int pt = (tid - 128) & 255, tok = pt >> 3, part = pt & 7, c0 = part * 8, hc = h * 64 + c0, vcol = h * 64 + rg * 8;
    float kkc[8], kac[8], rrk[8], mur[8], muk[8], muw[8], mua[8], muv[8];
#pragma unroll
    for (int j = 0; j < 8; ++j) { kkc[j] = P.rkk[hc + j]; kac[j] = P.rka[hc + j]; rrk[j] = P.rrk[hc + j]; mur[j] = P.rmu[hc + j]; muk[j] = P.rmu[1024 + hc + j]; muw[j] = P.rmu[3072 + c0 + j]; mua[j] = P.rmu[3136 + c0 + j]; muv[j] = P.rmu[2048 + vcol + j]; }
    const int lr_ = lane & 31, lh = lane >> 5;
    const int mat = ((wave - 2) >> 1) & 1, mct = wave & 1, mcc = mct * 32 + lr_;
    bf16x8 bfr[4];
    { const bf16* Bg = (mat ? A2T : W2T) + (size_t)(h * 64 + mcc) * 64;
#pragma unroll
      for (int ks = 0; ks < 4; ++ks) bfr[ks] = *(const bf16x8*)(Bg + ks * 16 + 8 * lh); }
    const float mbias = mat ? P.ra0[h * 64 + mcc] : P.rw0[h * 64 + mcc];
    const int rl = lane >> 4, q4 = (lane & 15) * 4, ro = (wave & 1) * 4 + rl;
    f32x4 S = {0.f, 0.f, 0.f, 0.f};
    RawRows R; float r8[8], k8[8];
    if (is_prep) rw_load(R, RR, RK, RV, LR, b * T + tok, tok, hc, c0, vcol, part == 0);
#define PREP1(cc) do { const RwBuf B_ = rw_buf(lds, (cc) & 1); const int t_ = (cc) * RCH + tok, row_ = b * T + t_; \
        lerp8(R.rc, R.rp, mur, r8); lerp8(R.kc, R.kp, muk, k8); \
        { float w8[8], a8[8]; lerp8(R.wc, R.wp, muw, w8); lerp8(R.ac, R.ap, mua, a8); \
          _Pragma("unroll") for (int j = 0; j < 8; ++j) { const float e2 = __expf(2.f * w8[j]); w8[j] = 1.f - 2.f * __builtin_amdgcn_rcpf(e2 + 1.f); } \
          v4u pw, pa; pw.x = pk2(w8[0], w8[1]); pw.y = pk2(w8[2], w8[3]); pw.z = pk2(w8[4], w8[5]); pw.w = pk2(w8[6], w8[7]); \
          pa.x = pk2(a8[0], a8[1]); pa.y = pk2(a8[2], a8[3]); pa.z = pk2(a8[4], a8[5]); pa.w = pk2(a8[6], a8[7]); \
          *(LAS v4u*)(TW + tok * 72 + c0) = pw; *(LAS v4u*)(TA + tok * 72 + c0) = pa; } \
        if (part == 0) { float v8[8]; lerp8(R.vc, R.vp, muv, v8); _Pragma("unroll") for (int j = 0; j < 8; ++j) B_.Vv[tok * 8 + j] = v8[j]; } \
        if ((cc) + 1 < NRCH) rw_load(R, RR, RK, RV, LR, row_ + RCH, t_ + RCH, hc, c0, vcol, part == 0); } while (0)
#define PREP2(cc) do { const RwBuf B_ = rw_buf(lds, (cc) & 1); const LAS bf16* As = mat ? TA : TW; f32x16 acc; \
        _Pragma("unroll") for (int j = 0; j < 16; ++j) acc[j] = 0.f; \
        _Pragma("unroll") for (int ks = 0; ks < 4; ++ks) { const bf16x8 a = *(const LAS bf16x8*)(As + lr_ * 72 + ks * 16 + 8 * lh); acc = MFMA32(a, bfr[ks], acc); } \
        _Pragma("unroll") for (int r = 0; r < 16; ++r) { const int tk = (r & 3) + 8 * (r >> 2) + 4 * lh; const float z = mbias + acc[r]; \
            if (mat) AL[tk * 64 + mcc] = __builtin_amdgcn_rcpf(1.f + __expf(-z)); \
            else { const float sp = fmaxf(-z, 0.f) + __logf(1.f + __expf(-fabsf(z))); B_.Wd[tk * 64 + mcc] = __expf(-__expf(-sp - 0.5f)); } } } while (0)
#define PREP3(cc) do { const RwBuf B_ = rw_buf(lds, (cc) & 1); const int row_ = b * T + (cc) * RCH + tok; float ss = 0.f, kkv[8]; \
        _Pragma("unroll") for (int j = 0; j < 8; ++j) { kkv[j] = k8[j] * kkc[j]; ss += kkv[j] * kkv[j]; } \
        ss = red8(ss); const float inv = __builtin_amdgcn_rcpf(fmaxf(sqrtf(ss), 1e-12f)); float br = 0.f, kr = 0.f, cs = 0.f; \
        const f32x4 al0 = *(const LAS f32x4*)(AL + tok * 64 + c0), al1 = *(const LAS f32x4*)(AL + tok * 64 + c0 + 4), wd0 = *(const LAS f32x4*)(B_.Wd + tok * 64 + c0), wd1 = *(const LAS f32x4*)(B_.Wd + tok * 64 + c0 + 4); \
        f32x4 oa[2], ob[2], ok[2], orw[2]; \
        _Pragma("unroll") for (int j = 0; j < 8; ++j) { const float al = j < 4 ? al0[j & 3] : al1[j & 3], w = j < 4 ? wd0[j & 3] : wd1[j & 3], kk = kkv[j] * inv, kp = k8[j] * (1.f + (al - 1.f) * kac[j]), bb = kk * al; \
            oa[j >> 2][j & 3] = -kk; ob[j >> 2][j & 3] = bb; ok[j >> 2][j & 3] = kp; orw[j >> 2][j & 3] = r8[j] * w; br += bb * r8[j]; kr += kp * r8[j]; cs += r8[j] * kp * rrk[j]; } \
        _Pragma("unroll") for (int i = 0; i < 2; ++i) { *(LAS f32x4*)(B_.Aa + tok * 64 + c0 + 4 * i) = oa[i]; *(LAS f32x4*)(B_.Bb + tok * 64 + c0 + 4 * i) = ob[i]; *(LAS f32x4*)(B_.Kp + tok * 64 + c0 + 4 * i) = ok[i]; *(LAS f32x4*)(B_.RW + tok * 64 + c0 + 4 * i) = orw[i]; } \
        br = red8(br); kr = red8(kr); cs = red8(cs); \
        if (part == 0) { B_.SC[tok * 2] = br; B_.SC[tok * 2 + 1] = kr; if (rg == 0) CTB[(size_t)row_ * 16 + h] = cs; } } while (0)
#define RECSEG(cc, lo, hi) do { const RwBuf B_ = rw_buf(lds, (cc) & 1); \
        f32x4 a = *(const LAS f32x4*)(B_.Aa + (lo) * 64 + q4), y = *(const LAS f32x4*)(B_.RW + (lo) * 64 + q4), w = *(const LAS f32x4*)(B_.Wd + (lo) * 64 + q4), bb = *(const LAS f32x4*)(B_.Bb + (lo) * 64 + q4), k = *(const LAS f32x4*)(B_.Kp + (lo) * 64 + q4); \
        float vv = B_.Vv[(lo) * 8 + ro], brr = B_.SC[(lo) * 2], krr = B_.SC[(lo) * 2 + 1]; \
        for (int tk = (lo); tk < (hi); ++tk) { const int tn = tk + 1 < (hi) ? tk + 1 : tk; \
            const f32x4 an = *(const LAS f32x4*)(B_.Aa + tn * 64 + q4), yn = *(const LAS f32x4*)(B_.RW + tn * 64 + q4), wn = *(const LAS f32x4*)(B_.Wd + tn * 64 + q4), bn = *(const LAS f32x4*)(B_.Bb + tn * 64 + q4), kn = *(const LAS f32x4*)(B_.Kp + tn * 64 + q4); \
            const float vn = B_.Vv[tn * 8 + ro], brn = B_.SC[tn * 2], krn = B_.SC[tn * 2 + 1]; \
            float psa = (S[0] * a[0] + S[1] * a[1]) + (S[2] * a[2] + S[3] * a[3]); float py = (S[0] * y[0] + S[1] * y[1]) + (S[2] * y[2] + S[3] * y[3]); \
            const f32x4 u = k * vv, sw = S * w; psa = red16(psa); py = red16(py); S = sw + (bb * psa + u); \
            B_.YB[tk * 8 + ro] = py + psa * brr + vv * krr; \
            a = an; y = yn; w = wn; bb = bn; k = kn; vv = vn; brr = brn; krr = krn; } } while (0)
    if (is_prep) PREP1(0);
    __syncthreads();
    if (is_prep) PREP2(0);
    __syncthreads();
    if (is_prep) PREP3(0);
    __syncthreads();
    for (int ch = 0; ch < NRCH; ++ch) {
        if (is_rec) RECSEG(ch, 0, 11);
        if (is_prep && ch + 1 < NRCH) PREP1(ch + 1);
        if (is_flush && ch > 0 && lane < 32) { const RwBuf B_ = rw_buf(lds, (ch - 1) & 1); const LAS float* yb = B_.YB + lane * 8;
            v4u o; o.x = pk2(yb[0], yb[1]); o.y = pk2(yb[2], yb[3]); o.z = pk2(yb[4], yb[5]); o.w = pk2(yb[6], yb[7]);
            *(v4u*)(YR + (size_t)(b * T + (ch - 1) * RCH + lane) * 1024 + vcol) = o; }
        __syncthreads();
        if (is_rec) RECSEG(ch, 11, 22);
        if (is_prep && ch + 1 < NRCH) PREP2(ch + 1);
        __syncthreads();
        if (is_rec) RECSEG(ch, 22, 32);
        if (is_prep && ch + 1 < NRCH) PREP3(ch + 1);
        __syncthreads();
    }
    if (is_flush && lane < 32) { const RwBuf B_ = rw_buf(lds, (NRCH - 1) & 1); const LAS float* yb = B_.YB + lane * 8;
        v4u o; o.x = pk2(yb[0], yb[1]); o.y = pk2(yb[2], yb[3]); o.z = pk2(yb[4], yb[5]); o.w = pk2(yb[6], yb[7]);
        *(v4u*)(YR + (size_t)(b * T + (NRCH - 1) * RCH + lane) * 1024 + vcol) = o; }
    __syncthreads();
#undef PREP1
#undef PREP2
#undef PREP3
#undef RECSEG
}
__device__ __forceinline__ void rwkv_post(const Ptrs& P, LAS unsigned char* lds, int tile, int tid, int wave, int lane) {
    const bf16* RV = (const bf16*)(P.ws + WS_RV); const bf16* LR = (const bf16*)(P.ws + WS_LR); bf16* YR = (bf16*)(P.ws + WS_YR); const float* CTB = (const float*)(P.ws + WS_CT);
    const bf16* G2T = (const bf16*)(P.ws + WS_G2T);
    LAS bf16* SG = (LAS bf16*)lds;
    LAS float* ST = (LAS float*)(lds + 64 * 136 * 2);
    const int tok = tid >> 3, part = tid & 7, row = tile * 64 + tok, t = row & (T - 1);
#pragma unroll
    for (int i = 0; i < 2; ++i) { const int c0 = part * 16 + i * 8; float mu[8], g8[8];
#pragma unroll
        for (int j = 0; j < 8; ++j) mu[j] = P.rmu[3200 + c0 + j];
        shift8(LR, 256, row, t, 128 + c0, mu, g8);
        v4u pg; pg.x = pk2(sigm(g8[0]), sigm(g8[1])); pg.y = pk2(sigm(g8[2]), sigm(g8[3])); pg.z = pk2(sigm(g8[4]), sigm(g8[5])); pg.w = pk2(sigm(g8[6]), sigm(g8[7]));
        *(LAS v4u*)(SG + tok * 136 + c0) = pg; }
#pragma unroll
    for (int i = 0; i < 2; ++i) { const int hd = part * 2 + i; float s = 0.f, s2 = 0.f;
#pragma unroll
        for (int k = 0; k < 8; ++k) { float x8[8]; unpack8(*(const v4u*)(YR + (size_t)row * 1024 + hd * 64 + k * 8), x8);
#pragma unroll
            for (int j = 0; j < 8; ++j) { s += x8[j]; s2 += x8[j] * x8[j]; } }
        const float mean = s * (1.f / 64.f); const float var = fmaxf(s2 * (1.f / 64.f) - mean * mean, 0.f);
        ST[(tok * 16 + hd) * 2] = mean; ST[(tok * 16 + hd) * 2 + 1] = 1.f / sqrtf(var + 64e-5f); }
    __syncthreads();
    const int lr_ = lane & 31, lh = lane >> 5;
    for (int hf = 0; hf < 2; ++hf) {
        f32x16 acc[2][2];
#pragma unroll
        for (int i = 0; i < 2; ++i)
#pragma unroll
            for (int j = 0; j < 2; ++j)
#pragma unroll
                for (int r = 0; r < 16; ++r) acc[i][j][r] = 0.f;
        const int cbase = wave * 128 + hf * 64;
#pragma unroll 2
        for (int ks = 0; ks < 8; ++ks) {
            bf16x8 a[2];
#pragma unroll
            for (int i = 0; i < 2; ++i) a[i] = *(const LAS bf16x8*)(SG + (i * 32 + lr_) * 136 + ks * 16 + 8 * lh);
#pragma unroll
            for (int j = 0; j < 2; ++j) { const bf16x8 bb = *(const bf16x8*)(G2T + (size_t)(cbase + j * 32 + lr_) * 128 + ks * 16 + 8 * lh);
#pragma unroll
                for (int i = 0; i < 2; ++i) acc[i][j] = MFMA32(a[i], bb, acc[i][j]); }
        }
        LAS bf16* GL = (LAS bf16*)(lds + 32768) + wave * (64 * 72);
#pragma unroll
        for (int j = 0; j < 2; ++j)
#pragma unroll
            for (int i = 0; i < 2; ++i)
#pragma unroll
                for (int r = 0; r < 16; ++r) GL[(i * 32 + (r & 3) + 8 * (r >> 2) + 4 * lh) * 72 + j * 32 + lr_] = (bf16)f2bf(acc[i][j][r]);
        asm volatile("s_waitcnt lgkmcnt(0)" ::: "memory");
        const int c8 = (lane & 7) * 8, chn0 = cbase + c8, hd = chn0 >> 6;
        float gg[8], gb[8], muv[8];
#pragma unroll
        for (int j = 0; j < 8; ++j) { gg[j] = P.gng[chn0 + j]; gb[j] = P.gnb[chn0 + j]; muv[j] = P.rmu[2048 + chn0 + j]; }
#pragma unroll 1
        for (int p = 0; p < 8; ++p) { const int tk = p * 8 + (lane >> 3), rw_ = tile * 64 + tk, tt = rw_ & (T - 1);
            float y8[8], v8[8], g8[8]; unpack8(*(const v4u*)(YR + (size_t)rw_ * 1024 + chn0), y8); shift8(RV, 1024, rw_, tt, chn0, muv, v8); unpack8(*(const LAS v4u*)(GL + tk * 72 + c8), g8);
            const float mean = ST[(tk * 16 + hd) * 2], rstd = ST[(tk * 16 + hd) * 2 + 1], ctv = CTB[(size_t)rw_ * 16 + hd];
            float o[8];
#pragma unroll
            for (int j = 0; j < 8; ++j) o[j] = (((y8[j] - mean) * rstd * gg[j] + gb[j]) + ctv * v8[j]) * g8[j];
            v4u w; w.x = pk2(o[0], o[1]); w.y = pk2(o[2], o[3]); w.z = pk2(o[4], o[5]); w.w = pk2(o[6], o[7]);
            *(v4u*)(YR + (size_t)rw_ * 1024 + chn0) = w; }
        asm volatile("s_waitcnt lgkmcnt(0)" ::: "memory");
    }
    __syncthreads();
}

struct Args { Ptrs p; int ph_lo, ph_hi, coop, pad; };
constexpr int N_PHASES = 18;
__global__ void __launch_bounds__(NTHR, 2) mk_fwd(Args args) {
    extern __shared__ __attribute__((aligned(16))) unsigned char lds_raw[];
    LAS unsigned char* lds = (LAS unsigned char*)lds_raw;
    const Ptrs& P = args.p;
    const int tid = threadIdx.x, lane = tid & 63, wave = __builtin_amdgcn_readfirstlane(tid >> 6);
    const int G = gridDim.x, bx = blockIdx.x, gw = bx * NWAVES + wave, NGW = G * NWAVES;
    unsigned char* ws = P.ws;
    bf16* XB = (bf16*)(ws + WS_XB); bf16* HB = (bf16*)(ws + WS_H);
    bf16* BB = (bf16*)(ws + WS_B); bf16* CBf = (bf16*)(ws + WS_C); bf16* DB = (bf16*)(ws + WS_D);
    const int lo = args.ph_lo, hi = args.ph_hi;
#ifndef PH_MASK
#define PH_MASK 0x3FFFF
#endif
#define IN(k) ((((PH_MASK) >> (k)) & 1) && lo <= (k) && (k) < hi)
#ifndef REP_MASK
#define REP_MASK 0
#endif
#define REP(k) for (int rep_ = 0; rep_ < ((((REP_MASK) >> (k)) & 1) + 1); ++rep_)
#define SEAM(k) do { if (IN(k) && IN((k) + 1)) { cg::this_grid().sync(); } } while (0)
    LAS float* scr = (LAS float*)(lds + wave * 16384);

    if (IN(0)) REP(0) {
        conv_mat<1>(P.f1g, P.f1u, FF, D, (bf16*)(ws + WS_WF), 5632, scr, gw, NGW, lane);
        conv_mat<0>(P.f1d, nullptr, D, FF, (bf16*)(ws + WS_WFD), 1024, scr, gw, NGW, lane);
        conv_mat<2>(P.win, nullptr, WIN_LD, D, (bf16*)(ws + WS_WIN1), 3328, scr, gw, NGW, lane);
        conv_mat<3>(P.win, nullptr, WIN_LD, D, (bf16*)(ws + WS_WIN2), 3328, scr, gw, NGW, lane);
        conv_mat<4>(P.win, nullptr, WIN_LD, D, (bf16*)(ws + WS_WIN3), 3072, scr, gw, NGW, lane);
        conv_mat<0>(P.wa, nullptr, D, D, (bf16*)(ws + WS_WA), 1024, scr, gw, NGW, lane);
        conv_mat<0>(P.wb, nullptr, D, D, (bf16*)(ws + WS_WB), 1024, scr, gw, NGW, lane);
        conv_mat<0>(P.wo, nullptr, D, D, (bf16*)(ws + WS_WO), 1024, scr, gw, NGW, lane);
        conv_mat<0>(P.rw2, nullptr, D, 64, (bf16*)(ws + WS_W2T), 1024, scr, gw, NGW, lane);
        conv_mat<0>(P.ra2, nullptr, D, 64, (bf16*)(ws + WS_A2T), 1024, scr, gw, NGW, lane);
        conv_mat<0>(P.rg2, nullptr, D, 128, (bf16*)(ws + WS_G2T), 1024, scr, gw, NGW, lane);
        cvt_rows_bf16(P.x, XB, gw, NGW, lane);
    }
    SEAM(0);
    if (IN(1)) REP(1) { pg8::Gemm g{XB, (const bf16*)(ws + WS_WF), M, 5632, D}; pg8::StaticOrder S; S.init(M, 5632, G, bx); pg8::EpiSwiGLU E{HB, FF};
        pg8::gemm_phase<pg8::EpiSwiGLU, pg8::StaticOrder, true, true>(lds, g, S, E); }
    SEAM(1);
    if (IN(2)) { pg8::Gemm g{HB, (const bf16*)(ws + WS_WFD), M, D, FF}; pg8::StaticOrder S; S.init(M, D, G, bx); pg8::EpiResid E{P.x, P.out, D, ALPHA, 0.5f};
        pg8::gemm_phase<pg8::EpiResid, pg8::StaticOrder, true, true>(lds, g, S, E); }
    SEAM(2);
    if (IN(3)) {
        ln_rows(P.out, P.ln1g, P.ln1b, P.out, XB, gw, NGW, lane);
        conv_mat<1>(P.f2g, P.f2u, FF, D, (bf16*)(ws + WS_WF), 5632, scr, gw, NGW, lane);
        conv_mat<0>(P.f2d, nullptr, D, FF, (bf16*)(ws + WS_WFD), 1024, scr, gw, NGW, lane);
    }
    SEAM(3);
    if (IN(4)) REP(4) { pg8::Gemm g{XB, (const bf16*)(ws + WS_WIN1), M, 3328, D}; pg8::StaticOrder S; S.init(M, 3328, G, bx);
        typedef pg8::EpiSplit<0, (long)(WS_C - WS_B) / 2, (long)(WS_D - WS_B) / 2> EP; EP E{BB, nullptr, (float*)(ws + WS_GATES), P.ib, P.fb};
        pg8::gemm_phase<EP, pg8::StaticOrder, true, true>(lds, g, S, E); }
    SEAM(4);
    if (IN(5)) REP(5) { for (int u = bx; u < 512; u += G) mlstm_passA(P, lds, u, tid, wave, lane); }
    SEAM(5);
    if (IN(6)) { mlstm_passB(P, bx * NTHR + tid, G * NTHR); }
    SEAM(6);
    if (IN(7)) { for (int u = bx; u < 512; u += G) mlstm_passC(P, lds, u, tid, wave, lane); }
    SEAM(7);
    if (IN(8)) REP(8) { pg8::Gemm g{XB, (const bf16*)(ws + WS_WIN2), M, 3328, D}; pg8::StaticOrder S; S.init(M, 3328, G, bx);
        typedef pg8::EpiSplit<1, (long)(WS_C - WS_B) / 2, (long)(WS_RV - WS_B) / 2> EP; EP E{BB, (bf16*)(ws + WS_LR), nullptr, nullptr, nullptr};
        pg8::gemm_phase<EP, pg8::StaticOrder, true, true>(lds, g, S, E); }
    SEAM(8);
    if (IN(9)) REP(9) { for (int u = bx; u < 256; u += G) rwkv_unit(P, lds, u, tid, wave, lane); }
    SEAM(9);
    if (IN(10)) { for (int u = bx; u < M / 64; u += G) rwkv_post(P, lds, u, tid, wave, lane); }
    SEAM(10);
    if (IN(11)) { pg8::Gemm g{XB, (const bf16*)(ws + WS_WIN3), M, 3072, D}; pg8::StaticOrder S; S.init(M, 3072, G, bx);
        typedef pg8::EpiSplit<2, -(long)(WS_D - WS_C) / 2, -(long)(WS_D - WS_B) / 2> EP; EP E{DB, nullptr, nullptr, nullptr, nullptr};
        pg8::gemm_phase<EP, pg8::StaticOrder, true, true>(lds, g, S, E); }
    SEAM(11);
    if (IN(12)) {
        { pg8::Gemm g{DB, (const bf16*)(ws + WS_WA), M, D, D}; pg8::StaticOrder S; S.init(M, D, G, bx); pg8::EpiBranch<false> E{CBf, nullptr};
          pg8::gemm_phase<pg8::EpiBranch<false>, pg8::StaticOrder, true, true>(lds, g, S, E); }
        __syncthreads();
        { pg8::Gemm g{(const bf16*)(ws + WS_YR), (const bf16*)(ws + WS_WB), M, D, D}; pg8::StaticOrder S; S.init(M, D, G, bx); pg8::EpiBranch<true> E{BB, CBf};
          pg8::gemm_phase<pg8::EpiBranch<true>, pg8::StaticOrder, true, true>(lds, g, S, E); }
    }
    SEAM(12);
    if (IN(13)) { pg8::Gemm g{BB, (const bf16*)(ws + WS_WO), M, D, D}; pg8::StaticOrder S; S.init(M, D, G, bx); pg8::EpiResid E{P.out, P.out, D, ALPHA, 1.0f};
        pg8::gemm_phase<pg8::EpiResid, pg8::StaticOrder, true, true>(lds, g, S, E); }
    SEAM(13);
    if (IN(14)) { ln_rows(P.out, P.ln2g, P.ln2b, P.out, XB, gw, NGW, lane); }
    SEAM(14);
    if (IN(15)) { pg8::Gemm g{XB, (const bf16*)(ws + WS_WF), M, 5632, D}; pg8::StaticOrder S; S.init(M, 5632, G, bx); pg8::EpiSwiGLU E{HB, FF};
        pg8::gemm_phase<pg8::EpiSwiGLU, pg8::StaticOrder, true, true>(lds, g, S, E); }
    SEAM(15);
    if (IN(16)) { pg8::Gemm g{HB, (const bf16*)(ws + WS_WFD), M, D, FF}; pg8::StaticOrder S; S.init(M, D, G, bx); pg8::EpiResid E{P.out, P.out, D, ALPHA, 0.5f};
        pg8::gemm_phase<pg8::EpiResid, pg8::StaticOrder, true, true>(lds, g, S, E); }
    SEAM(16);
    if (IN(17)) { ln_rows(P.out, P.ln3g, P.ln3b, P.out, nullptr, gw, NGW, lane); }
#undef IN
#undef SEAM
}

#ifndef MK_N_LAUNCHES
#define MK_N_LAUNCHES 1
#endif
extern "C" void kernel_launch(void* const* d_in, const int* in_sizes, int n_in, void* d_out, int out_size, void* d_ws, size_t ws_size, hipStream_t stream) {
    static int grid = 0;
    if (grid == 0) {
        int dev = 0, cus = 0, per_cu = 0;
        hipGetDevice(&dev); hipDeviceGetAttribute(&cus, hipDeviceAttributeMultiprocessorCount, dev);
        hipFuncSetAttribute((const void*)mk_fwd, hipFuncAttributeMaxDynamicSharedMemorySize, LDS_BYTES);
        hipOccupancyMaxActiveBlocksPerMultiprocessor(&per_cu, (const void*)mk_fwd, NTHR, LDS_BYTES);
        if (per_cu < 1) { fprintf(stderr, "kernel_launch: occupancy query reports %d blocks per CU\n", per_cu); per_cu = 1; }
        grid = cus;
        if (n_in != 33 || ws_size < WS_END) fprintf(stderr, "kernel_launch: unexpected n_in %d / ws_size %zu\n", n_in, ws_size);
        (void)hipGetLastError();
    }
    Args a{};
    const float** pp = (const float**)&a.p;
    for (int i = 0; i < 33; ++i) pp[i] = (const float*)d_in[i];
    a.p.out = (float*)d_out; a.p.ws = (unsigned char*)d_ws;
    if (MK_N_LAUNCHES == 1) {
        a.ph_lo = 0; a.ph_hi = N_PHASES; a.coop = 1;
        void* kargs[] = {&a};
        hipError_t e = hipLaunchCooperativeKernel((const void*)mk_fwd, dim3(grid), dim3(NTHR), kargs, LDS_BYTES, stream);
        if (e != hipSuccess) fprintf(stderr, "cooperative launch failed: %s (grid %d)\n", hipGetErrorString(e), grid);
    } else {
        for (int ph = 0; ph < N_PHASES; ++ph) { a.ph_lo = ph; a.ph_hi = ph + 1; a.coop = 0; hipLaunchKernelGGL(mk_fwd, dim3(grid), dim3(NTHR), LDS_BYTES, stream, a); }
    }
}
```
